# Optimizing an MI355X kernel written in HIP

```python
import math
import jax, jax.numpy as jnp
from jax import lax
import numpy as np

D_MODEL = 2048
BATCH = 4
SEQ = 4096
DEPTH = 4

HEAD_DIM = 128
N_HEADS_A = 8
N_HEADS_B = 8
WIDTH_A = N_HEADS_A * HEAD_DIM
WIDTH_B = N_HEADS_B * HEAD_DIM
MIX_WIDTH = WIDTH_A + WIDTH_B
IN_WIDTH = 3 * MIX_WIDTH
DILATED_PATTERNS = ((128, 1), (512, 4), (2048, 16))
ROPE_THETA = 10000.0
SB_BLOCK = 128
PEER_HEADS = 8
PEER_N_KEYS = 128
PEER_N_EXPERTS = PEER_N_KEYS * PEER_N_KEYS
PEER_KEY_DIM = 256
PEER_KEY_HALF = PEER_KEY_DIM // 2
PEER_TOPK = 16
PEER_CHUNK = 128
PLE_DIM = 256
NORM_EPS = 1e-6
NEG_INF = -1e30

kernel_name = 'hybrid_dilated_stickbreaking_peer_block'

F32 = jnp.float32


def rms_norm(x, g):
    xf = x.astype(F32)
    y = xf * lax.rsqrt(jnp.mean(xf * xf, axis=-1, keepdims=True) + NORM_EPS)
    return (y * g.astype(F32)).astype(x.dtype)


def apply_rope(x, positions):
    half = HEAD_DIM // 2
    inv_freq = ROPE_THETA ** (-jnp.arange(half, dtype=F32) / half)
    ang = positions.astype(F32)[..., None] * inv_freq
    cos = jnp.cos(ang)[:, :, None, :]
    sin = jnp.sin(ang)[:, :, None, :]
    xf = x.astype(F32)
    x1, x2 = xf[..., :half], xf[..., half:]
    out = jnp.concatenate([x1 * cos - x2 * sin, x2 * cos + x1 * sin], axis=-1)
    return out.astype(x.dtype)


def causal_band_attention(q, k, v, w):
    n, L, h, hd = q.shape
    nb = -(-L // w)
    pad = nb * w - L
    def blocks(a):
        a = jnp.pad(a.astype(F32), ((0, 0), (0, pad), (0, 0), (0, 0)))
        return a.reshape(n, nb, w, h, hd)
    qb, kb, vb = blocks(q), blocks(k), blocks(v)
    def with_prev(a):
        prev = jnp.concatenate([jnp.zeros_like(a[:, :1]), a[:, :-1]], axis=1)
        return jnp.concatenate([prev, a], axis=2)
    kk, vv = with_prev(kb), with_prev(vb)
    s = jnp.einsum('nbqhd,nbkhd->nbhqk', qb, kk) * (hd ** -0.5)
    qi = jnp.arange(w)[:, None]
    kj = jnp.arange(2 * w)[None, :]
    rel = qi + w - kj
    band = (rel >= 0) & (rel <= w)
    key_ok = (jnp.arange(nb)[:, None, None] > 0) | (kj[None] >= w)
    mask = band[None] & key_ok
    s = jnp.where(mask[None, :, None], s, NEG_INF)
    m = jnp.max(s, axis=-1, keepdims=True)
    pe = jnp.exp(s - m)
    l = jnp.sum(pe, axis=-1, keepdims=True)
    o = jnp.einsum('nbhqk,nbkhd->nbqhd', pe / l, vv)
    lse = jnp.swapaxes((m + jnp.log(l))[..., 0], 2, 3)
    o = o.reshape(n, nb * w, h, hd)[:, :L]
    lse = lse.reshape(n, nb * w, h)[:, :L]
    return o, lse


def dilated_attention(q, k, v):
    b, s, h, hd = q.shape
    outs, lses = [], []
    for window, d in DILATED_PATTERNS:
        L = s // d
        def to_strided(a):
            return a.reshape(b, L, d, h, hd).transpose(0, 2, 1, 3, 4).reshape(b * d, L, h, hd)
        o, lse = causal_band_attention(to_strided(q), to_strided(k), to_strided(v), window // d)
        outs.append(o.reshape(b, d, L, h, hd).transpose(0, 2, 1, 3, 4).reshape(b, s, h, hd))
        lses.append(lse.reshape(b, d, L, h).transpose(0, 2, 1, 3).reshape(b, s, h))
    wts = jax.nn.softmax(jnp.stack(lses, axis=0), axis=0)
    o = jnp.sum(wts[..., None] * jnp.stack(outs, axis=0), axis=0)
    return o.astype(q.dtype)


def stick_breaking_attention(q, k, v):
    b, s, h, hd = q.shape
    nb = s // SB_BLOCK
    scale = hd ** -0.5
    kf, vf = k.astype(F32), v.astype(F32)
    qblocks = q.reshape(b, nb, SB_BLOCK, h, hd).transpose(1, 0, 2, 3, 4)
    key_pos = jnp.arange(s)
    def block(args):
        i, qb = args
        z = jnp.einsum('bqhd,bkhd->bhqk', qb.astype(F32), kf) * scale
        t = i * SB_BLOCK + jnp.arange(SB_BLOCK)
        mask = key_pos[None, :] < t[:, None]
        log_1m = jnp.where(mask, jax.nn.log_sigmoid(-z), 0.0)
        later = lax.cumsum(log_1m, axis=3, reverse=True) - log_1m
        a = jnp.where(mask, jnp.exp(jax.nn.log_sigmoid(z) + later), 0.0)
        return jnp.einsum('bhqk,bkhd->bqhd', a, vf)
    o = lax.map(block, (jnp.arange(nb), qblocks))
    return o.transpose(1, 0, 2, 3, 4).reshape(b, s, h, hd).astype(q.dtype)


def peer_ffn(x, w_q, sub_keys, u_tab, v_tab):
    b, s, d = x.shape
    t = b * s
    xt = x.reshape(t, d)
    qr = (xt @ w_q).reshape(t, PEER_HEADS, 2, PEER_KEY_HALF).astype(F32)
    sc = jnp.einsum('thcd,hcnd->thcn', qr, sub_keys.astype(F32))
    top_s, top_i = lax.top_k(sc, PEER_TOPK)
    cand_s = top_s[:, :, 0, :, None] + top_s[:, :, 1, None, :]
    cand_i = top_i[:, :, 0, :, None] * PEER_N_KEYS + top_i[:, :, 1, None, :]
    best_s, best_j = lax.top_k(cand_s.reshape(t, PEER_HEADS, PEER_TOPK * PEER_TOPK), PEER_TOPK)
    expert = jnp.take_along_axis(cand_i.reshape(t, PEER_HEADS, PEER_TOPK * PEER_TOPK), best_j, axis=-1)
    gates = jax.nn.softmax(best_s, axis=-1)
    nc = t // PEER_CHUNK
    def chunk(args):
        xc, ec, gc = args
        u = u_tab[ec]
        hid = jax.nn.gelu(jnp.einsum('cd,chkd->chk', xc, u).astype(F32), approximate=False)
        a = (hid * gc).astype(v_tab.dtype)
        return jnp.einsum('chk,chkd->cd', a, v_tab[ec])
    out = lax.map(chunk, (xt.reshape(nc, PEER_CHUNK, d),
                          expert.reshape(nc, PEER_CHUNK, PEER_HEADS, PEER_TOPK),
                          gates.reshape(nc, PEER_CHUNK, PEER_HEADS, PEER_TOPK)))
    return out.reshape(b, s, d).astype(x.dtype)


def setup_inputs(seed: int = 0) -> dict:
    key = jax.random.key(seed)
    ks = jax.random.split(key, 20)
    def nrm(k, shape, scale):
        return jax.random.normal(k, shape, F32) * scale
    def gain(k, shape):
        return 1.0 + 0.02 * jax.random.normal(k, shape, F32)
    x = jax.random.normal(ks[0], (BATCH, SEQ, D_MODEL), F32)
    p = jax.random.normal(ks[1], (DEPTH, BATCH, SEQ, PLE_DIM), F32)
    is_start = jax.random.bernoulli(ks[2], 1.0 / 1024, (BATCH, SEQ)).at[:, 0].set(True)
    idx = jnp.broadcast_to(jnp.arange(SEQ, dtype=jnp.int32), (BATCH, SEQ))
    doc_start = lax.cummax(jnp.where(is_start, idx, 0), axis=1)
    positions = (idx - doc_start).astype(jnp.int32)
    return {
        'x': x,
        'p': p,
        'positions': positions,
        'attn_norm': gain(ks[3], (DEPTH, D_MODEL)),
        'w_in': nrm(ks[4], (DEPTH, D_MODEL, IN_WIDTH), D_MODEL ** -0.5),
        'out_norm_a': gain(ks[5], (DEPTH, WIDTH_A)),
        'out_norm_b': gain(ks[6], (DEPTH, WIDTH_B)),
        'w_out': nrm(ks[7], (DEPTH, MIX_WIDTH, D_MODEL), MIX_WIDTH ** -0.5),
        'ffn_norm': gain(ks[8], (DEPTH, D_MODEL)),
        'peer_wq': nrm(ks[9], (DEPTH, D_MODEL, PEER_HEADS * PEER_KEY_DIM), D_MODEL ** -0.5),
        'peer_subkeys': nrm(ks[10], (DEPTH, PEER_HEADS, 2, PEER_N_KEYS, PEER_KEY_HALF), PEER_KEY_HALF ** -0.5),
        'peer_u': nrm(ks[11], (DEPTH, PEER_N_EXPERTS, D_MODEL), D_MODEL ** -0.5),
        'peer_v': nrm(ks[12], (DEPTH, PEER_N_EXPERTS, D_MODEL), PEER_HEADS ** -0.5),
        'ple_norm': gain(ks[13], (DEPTH, D_MODEL)),
        'ple_gate': nrm(ks[14], (DEPTH, D_MODEL, D_MODEL), D_MODEL ** -0.5),
        'ple_proj': nrm(ks[15], (DEPTH, PLE_DIM, D_MODEL), PLE_DIM ** -0.5),
        'final_norm': gain(ks[16], (D_MODEL,)),
    }


def reference(x, p, positions, attn_norm, w_in, out_norm_a, out_norm_b, w_out, ffn_norm,
              peer_wq, peer_subkeys, peer_u, peer_v, ple_norm, ple_gate, ple_proj, final_norm):
    b, s, _ = x.shape
    splits = (WIDTH_A, 2 * WIDTH_A, 3 * WIDTH_A, 3 * WIDTH_A + WIDTH_B, 3 * WIDTH_A + 2 * WIDTH_B)
    h = x
    for i in range(DEPTH):
        hn = rms_norm(h, attn_norm[i])
        proj = hn @ w_in[i]
        qa, ka, va, qb, kb, vb = jnp.split(proj, splits, axis=-1)
        qa = apply_rope(qa.reshape(b, s, N_HEADS_A, HEAD_DIM), positions)
        ka = apply_rope(ka.reshape(b, s, N_HEADS_A, HEAD_DIM), positions)
        va = va.reshape(b, s, N_HEADS_A, HEAD_DIM)
        oa = dilated_attention(qa, ka, va).reshape(b, s, WIDTH_A)
        ob = stick_breaking_attention(qb.reshape(b, s, N_HEADS_B, HEAD_DIM),
                                      kb.reshape(b, s, N_HEADS_B, HEAD_DIM),
                                      vb.reshape(b, s, N_HEADS_B, HEAD_DIM)).reshape(b, s, WIDTH_B)
        mixed = jnp.concatenate([rms_norm(oa, out_norm_a[i]), rms_norm(ob, out_norm_b[i])], axis=-1)
        h = h + (mixed @ w_out[i]).astype(h.dtype)
        h = h + peer_ffn(rms_norm(h, ffn_norm[i]), peer_wq[i], peer_subkeys[i], peer_u[i], peer_v[i])
        gate = jax.nn.sigmoid((rms_norm(h, ple_norm[i]) @ ple_gate[i]).astype(F32))
        h = h + ((p[i] @ ple_proj[i]).astype(F32) * gate).astype(h.dtype)
    return rms_norm(h, final_norm)
```

```cpp
#include <hip/hip_runtime.h>
#include <cstdio>
#include <cstdint>
namespace pg8 {
#define PG8_LAS __attribute__((address_space(3)))
typedef unsigned short bf16_t;
typedef short bf16x8 __attribute__((ext_vector_type(8)));
typedef float f32x4 __attribute__((ext_vector_type(4)));
typedef unsigned u32x4 __attribute__((ext_vector_type(4)));
typedef int i32x8 __attribute__((ext_vector_type(8)));
constexpr int BM = 256, BK = 64, HALF = 128, HTB = HALF * BK * 2  , STAGE_BYTES = 8 * HTB, NXCD = 8, WGM = 8;

__host__ __device__ __forceinline__ int lds_byte(int r, int c) { const int st = (r >> 4) * 2 + (c >> 5), rr = r & 15, cc = c & 31, ob = rr * 64 + cc * 2; return st * 1024 + (ob ^ (((ob >> 9) & 1) << 5)); }
__host__ __device__ __forceinline__ void stage_rc(int b, int& R, int& C) { const int st = b / 1024, sb = b % 1024, swz = sb ^ (((sb >> 9) & 1) << 5); R = (st >> 1) * 16 + swz / 64; C = (st & 1) * 32 + (swz % 64) / 2; }
__host__ __device__ __forceinline__ int perm32(int rho) { const int n = rho >> 4, i = rho & 15; return 8 * (i >> 2) + 4 * n + (i & 3); }

struct Unit { int pm, pn; };
struct Gemm { const bf16_t* A; const bf16_t* Bt; int M, N, K; };

struct StaticOrder {
    int nM, nN, nwg, G, c;
    __host__ __device__ void init(int M, int N, int G_, int c_) { nM = M / BM; nN = N / BM; nwg = nM * nN; G = G_; c = c_; }
    __host__ __device__ bool next(int i, Unit& u) const {
        const long L = (long)i * G + c; if (L >= nwg) return false;
        int wgid = (int)L; { const int q = nwg / NXCD, r = nwg % NXCD, xcd = wgid % NXCD, off = wgid / NXCD; wgid = (xcd < r ? xcd * (q + 1) : r * (q + 1) + (xcd - r) * q) + off; }
        const int nig = WGM * nN, gid = wgid / nig, fm = gid * WGM, gsz = (nM - fm) < WGM ? (nM - fm) : WGM;
        u.pm = fm + ((wgid % nig) % gsz); u.pn = (wgid % nig) / gsz; return true;
    }
    __device__ __forceinline__ void a_ready(const Unit&) const {}
    __device__ __forceinline__ void done(const Unit&) const {}
};

__device__ __forceinline__ unsigned cvt_pk_bf16(float lo, float hi) { unsigned r; asm volatile("v_cvt_pk_bf16_f32 %0, %1, %2" : "=v"(r) : "v"(lo), "v"(hi)); return r; }
template <class Epi, class Sched, bool ALIGN_EPI = false, bool SP2 = false, int ES = 2, int SCALE_W = 127>
__device__ __forceinline__ void gemm_phase(PG8_LAS unsigned char* lds, const Gemm g, const Sched& S, const Epi& E) {
    int tid_ = threadIdx.x; asm volatile("" : "+v"(tid_));
    const int tid = tid_, wid = __builtin_amdgcn_readfirstlane(tid >> 6), lane = tid & 63, wr = wid >> 2, wc = wid & 3, fr = lane & 15, fq = lane >> 4;
    const int K = g.K, nt = K * ES / (BK * 2);
    unsigned voffA[2], voffB[2];
#pragma unroll
    for (int i = 0; i < 2; ++i) { int R, C; stage_rc(tid * 16 + i * 8192, R, C); const int Rb = Epi::PERM ? ((R & ~31) + perm32(R & 31)) : R;
        voffA[i] = (unsigned)(R * K * ES + C * 2); voffB[i] = (unsigned)(Rb * K * ES + C * 2); }
    const size_t kstep = (size_t)(BK * 2);
    const size_t hstep = (size_t)HALF * K * ES;
    const size_t tstep = 2 * hstep;
    const unsigned ldsw = (unsigned)wid * 1024u;
    const int aoff = lds_byte(wr * 64 + fr, fq * 8), boff = lds_byte(wc * 32 + fr, fq * 8);
#define PG8_SA(b, h) (((b) * 2 + (h)) * HTB)
#define PG8_SB(b, h) ((4 + (b) * 2 + (h)) * HTB)
#define PG8_STAGE(bufoff, gbase, voff) do { _Pragma("unroll") for (int _i = 0; _i < 2; ++_i) \
        __builtin_amdgcn_global_load_lds((const unsigned*)((const char*)(gbase) + (voff)[_i]), (PG8_LAS unsigned*)(lds + (bufoff) + ldsw + _i * 8192), 16, 0, 0); } while (0)
#define PG8_CAT8(lo_, hi_) (i32x8){(int)(lo_).x, (int)(lo_).y, (int)(lo_).z, (int)(lo_).w, (int)(hi_).x, (int)(hi_).y, (int)(hi_).z, (int)(hi_).w}
#define PG8_LDA(dst, b, h) do { if constexpr (ES == 2) { _Pragma("unroll") for (int m = 0; m < 4; ++m) _Pragma("unroll") for (int k = 0; k < 2; ++k) dst[m][k] = *(const PG8_LAS bf16x8*)(lds + PG8_SA(b, h) + aoff + m * 2048 + k * 1024); } \
        else { _Pragma("unroll") for (int m = 0; m < 4; ++m) { const u32x4 lo_ = *(const PG8_LAS u32x4*)(lds + PG8_SA(b, h) + aoff + m * 2048), hi_ = *(const PG8_LAS u32x4*)(lds + PG8_SA(b, h) + aoff + m * 2048 + 1024); dst##8[m] = PG8_CAT8(lo_, hi_); } } } while (0)
#define PG8_LDB(dst, b, h) do { if constexpr (ES == 2) { _Pragma("unroll") for (int n = 0; n < 2; ++n) _Pragma("unroll") for (int k = 0; k < 2; ++k) dst[n][k] = *(const PG8_LAS bf16x8*)(lds + PG8_SB(b, h) + boff + n * 2048 + k * 1024); } \
        else { _Pragma("unroll") for (int n = 0; n < 2; ++n) { const u32x4 lo_ = *(const PG8_LAS u32x4*)(lds + PG8_SB(b, h) + boff + n * 2048), hi_ = *(const PG8_LAS u32x4*)(lds + PG8_SB(b, h) + boff + n * 2048 + 1024); dst##8[n] = PG8_CAT8(lo_, hi_); } } } while (0)
#define PG8_MMA(ai, bj, At, Bt) do { __builtin_amdgcn_s_setprio(1); _Pragma("unroll") for (int m = 0; m < 4; ++m) _Pragma("unroll") for (int n = 0; n < 2; ++n) { \
        if constexpr (ES == 2) { _Pragma("unroll") for (int k = 0; k < 2; ++k) acc[ai][bj][m][n] = __builtin_amdgcn_mfma_f32_16x16x32_bf16(Bt[n][k], At[m][k], acc[ai][bj][m][n], 0, 0, 0); } \
        else asm volatile("v_mfma_scale_f32_16x16x128_f8f6f4 %0, %1, %2, %0, %3, %4 op_sel_hi:[0,0,0]" : "+v"(acc[ai][bj][m][n]) : "v"(Bt##8[n]), "v"(At##8[m]), "v"(sclw_), "v"(scla_));        } \
        __builtin_amdgcn_s_setprio(0); } while (0)
#define PG8_WAIT_V(n) asm volatile("s_waitcnt vmcnt(" #n ")" ::: "memory")
#define PG8_WAIT_L(n) asm volatile("s_waitcnt lgkmcnt(" #n ")" ::: "memory")
#define PG8_BAR __builtin_amdgcn_s_barrier()
#define PG8_SCHED __builtin_amdgcn_sched_barrier(0)
    Unit cur, nxt; int ui = 0;
    if (!S.next(0, cur)) return;
    f32x4 acc[2][2][4][2];
#pragma unroll
    for (int a = 0; a < 2; ++a)
#pragma unroll
        for (int b = 0; b < 2; ++b)
#pragma unroll
            for (int m = 0; m < 4; ++m)
#pragma unroll
                for (int n = 0; n < 2; ++n) acc[a][b][m][n] = (f32x4){0.f, 0.f, 0.f, 0.f};
    const int sclw_ = SCALE_W * 0x01010101, scla_ = 0x7f7f7f7f;
    bf16x8 At[4][2], B0[2][2], B1[2][2]; i32x8 At8[4], B08[2], B18[2];
    const char* cA = (const char*)g.A + (size_t)cur.pm * tstep; const char* cB = (const char*)g.Bt + (size_t)cur.pn * tstep;
    S.a_ready(cur);
    if constexpr (SP2) {
        PG8_STAGE(PG8_SB(0, 0), cB, voffB); PG8_STAGE(PG8_SB(0, 1), cB + hstep, voffB); PG8_STAGE(PG8_SA(0, 0), cA, voffA); PG8_STAGE(PG8_SA(0, 1), cA + hstep, voffA);
        if (wr == 1) PG8_BAR;
        PG8_WAIT_V(2); PG8_BAR;
        PG8_STAGE(PG8_SB(1, 0), cB + kstep, voffB); PG8_STAGE(PG8_SA(1, 0), cA + kstep, voffA); PG8_STAGE(PG8_SB(1, 1), cB + hstep + kstep, voffB);
        PG8_WAIT_V(6); PG8_BAR;
    } else {
        PG8_STAGE(PG8_SB(0, 0), cB, voffB); PG8_STAGE(PG8_SA(0, 0), cA, voffA); PG8_STAGE(PG8_SB(0, 1), cB + hstep, voffB); PG8_STAGE(PG8_SA(0, 1), cA + hstep, voffA);
        if (wr == 1) PG8_BAR;
        PG8_WAIT_V(4); PG8_BAR;
        PG8_STAGE(PG8_SB(1, 0), cB + kstep, voffB); PG8_STAGE(PG8_SA(1, 0), cA + kstep, voffA); PG8_STAGE(PG8_SB(1, 1), cB + hstep + kstep, voffB);
        PG8_WAIT_V(6); PG8_BAR;
    }
    for (;;) {
        const bool has_next = S.next(ui + 1, nxt);
        const char* nA = has_next ? (const char*)g.A + (size_t)nxt.pm * tstep : cA; const char* nB = has_next ? (const char*)g.Bt + (size_t)nxt.pn * tstep : cB;
        for (int t = 0; t < nt; t += 2) {
            const bool last = (t == nt - 2);
            const char* a1 = cA + (size_t)(t + 1) * kstep;
            const char* a2 = last ? nA : cA + (size_t)(t + 2) * kstep; const char* b2 = last ? nB : cB + (size_t)(t + 2) * kstep;
            const char* a3 = a2 + kstep; const char* b3 = b2 + kstep;
            if (last && has_next) S.a_ready(nxt);
            if constexpr (SP2) {
            PG8_LDB(B0, 0, 0); PG8_LDB(B1, 0, 1); PG8_SCHED; PG8_LDA(At, 0, 0); PG8_STAGE(PG8_SA(1, 1), a1 + hstep, voffA);
            PG8_WAIT_V(8); PG8_WAIT_L(0); PG8_BAR; PG8_MMA(0, 0, At, B0); PG8_MMA(0, 1, At, B1); PG8_BAR; PG8_SCHED;
            PG8_LDA(At, 0, 1); PG8_STAGE(PG8_SB(0, 0), b2, voffB); PG8_STAGE(PG8_SB(0, 1), b2 + hstep, voffB); PG8_STAGE(PG8_SA(0, 0), a2, voffA);
            PG8_WAIT_V(8); PG8_WAIT_L(0); PG8_BAR; PG8_MMA(1, 0, At, B0); PG8_MMA(1, 1, At, B1); PG8_BAR; PG8_SCHED;
            PG8_LDB(B0, 1, 0); PG8_LDB(B1, 1, 1); PG8_SCHED; PG8_LDA(At, 1, 0); PG8_STAGE(PG8_SA(0, 1), a2 + hstep, voffA);
            PG8_WAIT_V(8); PG8_WAIT_L(0); PG8_BAR; PG8_MMA(0, 0, At, B0); PG8_MMA(0, 1, At, B1); PG8_BAR; PG8_SCHED;
            PG8_LDA(At, 1, 1); PG8_STAGE(PG8_SB(1, 0), b3, voffB); PG8_STAGE(PG8_SB(1, 1), b3 + hstep, voffB); PG8_STAGE(PG8_SA(1, 0), a3, voffA);
            PG8_WAIT_V(8); PG8_WAIT_L(0); PG8_BAR; PG8_MMA(1, 0, At, B0); PG8_MMA(1, 1, At, B1); PG8_BAR; PG8_SCHED;
            } else {
            PG8_LDB(B0, 0, 0); PG8_SCHED; PG8_LDA(At, 0, 0); PG8_STAGE(PG8_SA(1, 1), a1 + hstep, voffA);
            PG8_WAIT_L(8); PG8_BAR; PG8_WAIT_L(0); PG8_MMA(0, 0, At, B0); PG8_BAR; PG8_SCHED;
            PG8_LDB(B1, 0, 1); PG8_STAGE(PG8_SB(0, 0), b2, voffB);
            PG8_BAR; PG8_WAIT_L(0); PG8_MMA(0, 1, At, B1); PG8_BAR;
            PG8_LDA(At, 0, 1); PG8_STAGE(PG8_SA(0, 0), a2, voffA);
            PG8_BAR; PG8_WAIT_L(0); PG8_MMA(1, 0, At, B0); PG8_BAR; PG8_SCHED;
            PG8_STAGE(PG8_SB(0, 1), b2 + hstep, voffB);
            PG8_WAIT_V(6); PG8_BAR; PG8_MMA(1, 1, At, B1); PG8_BAR;
            PG8_LDB(B0, 1, 0); PG8_SCHED; PG8_LDA(At, 1, 0); PG8_STAGE(PG8_SA(0, 1), a2 + hstep, voffA);
            PG8_WAIT_L(8); PG8_BAR; PG8_WAIT_L(0); PG8_MMA(0, 0, At, B0); PG8_BAR; PG8_SCHED;
            PG8_LDB(B1, 1, 1); PG8_STAGE(PG8_SB(1, 0), b3, voffB);
            PG8_BAR; PG8_WAIT_L(0); PG8_MMA(0, 1, At, B1); PG8_BAR;
            PG8_LDA(At, 1, 1); PG8_STAGE(PG8_SA(1, 0), a3, voffA);
            PG8_BAR; PG8_WAIT_L(0); PG8_MMA(1, 0, At, B0); PG8_BAR; PG8_SCHED;
            PG8_STAGE(PG8_SB(1, 1), b3 + hstep, voffB);
            PG8_WAIT_V(6); PG8_BAR; PG8_MMA(1, 1, At, B1); PG8_BAR;
            }
        }
        if constexpr (ALIGN_EPI) { if (wr == 0) PG8_BAR; }
#ifdef PROBE_EPI2
        if constexpr (!Epi::AFTER_DRAIN) { E(acc, cur, wr, wc, fr, fq); }
#endif
        if constexpr (!Epi::AFTER_DRAIN) { E(acc, cur, wr, wc, fr, fq); S.done(cur); }
        if (!has_next) break;
#pragma unroll
        for (int a = 0; a < 2; ++a)
#pragma unroll
            for (int b = 0; b < 2; ++b)
#pragma unroll
                for (int m = 0; m < 4; ++m)
#pragma unroll
                    for (int n = 0; n < 2; ++n) acc[a][b][m][n] = (f32x4){0.f, 0.f, 0.f, 0.f};
        cur = nxt; cA = nA; cB = nB; ++ui;
        if constexpr (ALIGN_EPI) { if (wr == 1) PG8_BAR; }
    }
    PG8_WAIT_V(0);
    if constexpr (!ALIGN_EPI) { if (wr == 0) PG8_BAR; }
    PG8_BAR;
    if constexpr (Epi::AFTER_DRAIN) { E.fused(acc, cur, wr, wc, fr, fq, lds, wid, lane); S.done(cur); }
#undef PG8_SA
#undef PG8_SB
#undef PG8_STAGE
#undef PG8_LDA
#undef PG8_LDB
#undef PG8_MMA
#undef PG8_WAIT_V
#undef PG8_WAIT_L
#undef PG8_BAR
#undef PG8_SCHED
}
}

#ifndef MK_N_LAUNCHES
#define MK_N_LAUNCHES 1
#endif
constexpr int BATCH = 4, SEQ = 4096, T = BATCH * SEQ, D = 2048, DEPTH = 4, INW = 6144, HD = 128, NH = 8, WA = 1024, QW = 4096;
constexpr int PLE = 256, NEXP = 16384, NKEYS = 128, TOPK = 16, PH = 8;
constexpr float EPS = 1e-6f;
constexpr int NWAVES = 8, NTHREADS = 512;
constexpr int PHASES_PER_LAYER = 10;
constexpr int NPH = 1 + DEPTH * PHASES_PER_LAYER + 1;
constexpr size_t MiB = 1u << 20;
constexpr size_t WS_CTL = 0, CTL_ZERO_BYTES = 1 * MiB;
constexpr size_t WS_WIN = 1 * MiB;
constexpr size_t WS_WOUT = 97 * MiB;
constexpr size_t WS_WQ = 129 * MiB;
constexpr size_t WS_WG = 161 * MiB;
constexpr size_t WS_WP = 193 * MiB;
constexpr size_t WS_ROPE = 197 * MiB;
constexpr size_t WS_SSQ = 199 * MiB;
constexpr size_t WS_IDS = 205 * MiB;
constexpr size_t WS_GATES = 213 * MiB;
constexpr size_t WS_PB = 221 * MiB;
constexpr size_t WS_U = 253 * MiB;
constexpr size_t WS_PART = 381 * MiB;
constexpr size_t WS_V = 509 * MiB;
constexpr size_t WS_AG = 637 * MiB;
constexpr size_t WS_H = 765 * MiB;
constexpr size_t WS_HBA = 893 * MiB;
constexpr size_t WS_HBB = 957 * MiB;
constexpr size_t WS_QKV = 1021 * MiB;
constexpr size_t WS_OAP = 1213 * MiB;
constexpr size_t WS_OBP = 1309 * MiB;
constexpr size_t WS_MIX = 1341 * MiB;
constexpr size_t WS_QR = 1405 * MiB;
constexpr size_t WS_PP = 1469 * MiB;
constexpr size_t WS_VT16 = 1534 * MiB;
constexpr size_t WS_VT1 = 1566 * MiB;
constexpr size_t WS_LSE = 1598 * MiB;
constexpr size_t WS_KT16 = 765 * MiB;
constexpr size_t WS_KT1 = 797 * MiB;
constexpr size_t WS_SKB = 1600 * MiB;
constexpr size_t WS_H8 = 1602 * MiB;
constexpr size_t WS_WG8 = 1634 * MiB;
constexpr size_t WS_HG8 = 1650 * MiB;
constexpr size_t WS_END = 1682 * MiB;
constexpr int CW_BAR = 4096;
constexpr int RING_BYTES = 131072, LDSCTL_OFF = RING_BYTES, MISC_OFF = LDSCTL_OFF + 320, LDS_BYTES = 147456;

#define GAS __attribute__((address_space(1)))
#define LAS __attribute__((address_space(3)))
typedef unsigned short bf16;
typedef unsigned v4u __attribute__((ext_vector_type(4)));
typedef unsigned v2u __attribute__((ext_vector_type(2)));
typedef float f32x4 __attribute__((ext_vector_type(4)));
typedef float f32x2 __attribute__((ext_vector_type(2)));
typedef __bf16 bf16x2_t __attribute__((ext_vector_type(2)));
#define LDS_WAIT() asm volatile("s_waitcnt lgkmcnt(0)" ::: "memory")

__device__ __forceinline__ unsigned f2bf(float f) { unsigned u = __builtin_bit_cast(unsigned, f); return (u + 0x7fffu + ((u >> 16) & 1u)) >> 16; }
__device__ __forceinline__ unsigned pk2(float lo, float hi) { unsigned r; asm("v_cvt_pk_bf16_f32 %0, %1, %2" : "=v"(r) : "v"(lo), "v"(hi)); return r; }
__device__ __forceinline__ float bflo(unsigned w) { return __builtin_bit_cast(float, w << 16); }
__device__ __forceinline__ float bfhi(unsigned w) { return __builtin_bit_cast(float, w & 0xffff0000u); }
__device__ __forceinline__ float dot2(unsigned a, unsigned b, float c) { return __builtin_amdgcn_fdot2_f32_bf16(__builtin_bit_cast(bf16x2_t, a), __builtin_bit_cast(bf16x2_t, b), c, false); }
__device__ __forceinline__ float wave_sum(float v) {
#pragma unroll
    for (int o = 1; o < 64; o <<= 1) v += __shfl_xor(v, o);
    return v;
}
__device__ __forceinline__ float wave_max(float v) {
#pragma unroll
    for (int o = 1; o < 64; o <<= 1) v = fmaxf(v, __shfl_xor(v, o));
    return v;
}
__device__ __forceinline__ void wave_argmax(float v, int idx, float& bv, int& bi) {
#pragma unroll
    for (int o = 32; o >= 1; o >>= 1) { const float ov = __shfl_xor(v, o); const int oi = __shfl_xor(idx, o); if (ov > v || (ov == v && oi < idx)) { v = ov; idx = oi; } }
    bv = v; bi = idx;
}

#define XB_TMO      128
#define XB_XCNT(j)  (256  + 64 * (j))
#define XB_XSUB(j)  (1280 + 64 * (j))
#define XB_XGEN(j)  (2304 + 64 * (j))
#define XB_TOP      3328
#define XB_TOPGEN   3392
#define XCD_BAR_WORDS 3456
#define XB_SPIN_CAP (1u << 22)
__device__ __forceinline__ unsigned xb_ld(unsigned* p)              { return __hip_atomic_load(p, __ATOMIC_RELAXED, __HIP_MEMORY_SCOPE_AGENT); }
__device__ __forceinline__ unsigned xb_add(unsigned* p, unsigned v) { return __hip_atomic_fetch_add(p, v, __ATOMIC_RELAXED, __HIP_MEMORY_SCOPE_AGENT); }
__device__ __forceinline__ unsigned xb_xcc_id() { return (unsigned)__builtin_amdgcn_s_getreg((3 << 11) | 20) & 0xFu; }
#define XB_SPIN(cond, bar) do { unsigned _sp = 0; while (cond) { __builtin_amdgcn_s_sleep(1); \
    if ((++_sp & 255u) == 0u) { if (xb_ld(&(bar)[XB_TMO])) break; if (_sp > XB_SPIN_CAP) { atomicAdd(&(bar)[XB_TMO], 1u); break; } } } } while (0)
struct XcdBarrier { unsigned* bar; unsigned x; volatile LAS unsigned* st; };
__device__ __forceinline__ XcdBarrier xcd_barrier_post(unsigned* bar, volatile LAS unsigned* st) {
    XcdBarrier b; b.bar = bar; b.x = xb_xcc_id(); b.st = st;
    if (threadIdx.x == 0) (void)xb_add(&bar[XB_XCNT(b.x)], 1u);
    return b;
}
__device__ __forceinline__ void xcd_barrier_complete(unsigned* bar, unsigned x, unsigned& nloc, unsigned& nx) {
    const unsigned G = gridDim.x * gridDim.y * gridDim.z;
    unsigned sum, cnt, mine, sp = 0u;
    for (;;) {
        sum = 0u; cnt = 0u; mine = 0u;
#pragma unroll
        for (unsigned j = 0; j < 16; ++j) { const unsigned c = xb_ld(&bar[XB_XCNT(j)]); sum += c; cnt += (c > 0u) ? 1u : 0u; mine = (j == x) ? c : mine; }
        if (sum == G) break;
        __builtin_amdgcn_s_sleep(1);
        if ((++sp & 255u) == 0u) { if (xb_ld(&bar[XB_TMO])) break; if (sp > XB_SPIN_CAP) { atomicAdd(&bar[XB_TMO], 1u); break; } }
    }
    nloc = mine > 0u ? mine : 1u; nx = cnt > 0u ? cnt : 1u;
}
__device__ __forceinline__ void xcd_barrier(const XcdBarrier& b) {
    asm volatile("s_waitcnt vmcnt(0)" ::: "memory");
    __syncthreads();
    if (threadIdx.x == 0) {
        unsigned* bar = b.bar;
        __builtin_amdgcn_s_waitcnt(0);
        unsigned nloc = b.st[0], nx = b.st[1];
        if (nloc == 0u) { xcd_barrier_complete(bar, b.x, nloc, nx); b.st[0] = nloc; b.st[1] = nx; }
        const unsigned old = xb_add(&bar[XB_XSUB(b.x)], 1u);
        const unsigned gen = old / nloc;
        if (old + 1u == (gen + 1u) * nloc) {
            __builtin_amdgcn_fence(__ATOMIC_RELEASE, "agent");
            asm volatile("s_waitcnt vmcnt(0)" ::: "memory");
            const unsigned og = xb_add(&bar[XB_TOP], 1u);
            const unsigned tg = og / nx;
            if (og + 1u == (tg + 1u) * nx) xb_add(&bar[XB_TOPGEN], 1u);
            else XB_SPIN(xb_ld(&bar[XB_TOPGEN]) == tg, bar);
            __builtin_amdgcn_fence(__ATOMIC_ACQUIRE, "agent");
            xb_add(&bar[XB_XGEN(b.x)], 1u);
            asm volatile("s_waitcnt vmcnt(0)" ::: "memory");
        } else {
            XB_SPIN(xb_ld(&bar[XB_XGEN(b.x)]) == gen, bar);
            __builtin_amdgcn_fence(__ATOMIC_ACQUIRE, "agent");
            asm volatile("s_waitcnt vmcnt(0)" ::: "memory");
        }
    }
    __syncthreads();
}

struct Args { const void* in[17]; float* out; unsigned char* ws; int ph_lo, ph_hi; };
#define CAS __attribute__((address_space(4)))
typedef const unsigned char CAS* kptr_t;
__device__ __forceinline__ kptr_t kargs() { kptr_t k = (kptr_t)__builtin_amdgcn_kernarg_segment_ptr(); asm volatile("" : "+s"(k)); return k; }
__device__ __forceinline__ const void* kin(kptr_t k, int i) { return *(const void* const CAS*)(k + 8 * i); }
__device__ __forceinline__ float* kout(kptr_t k) { return *(float* const CAS*)(k + 136); }
__device__ __forceinline__ unsigned char* kws(kptr_t k) { return *(unsigned char* const CAS*)(k + 144); }
struct Frame {
    LAS unsigned char* lds;
    int tid, lane, wave, G, gw, ngw;
    __device__ __forceinline__ void init(LAS unsigned char* l) { lds = l; int t_ = threadIdx.x, b_ = blockIdx.x, g_ = gridDim.x; asm volatile("" : "+v"(t_), "+s"(b_), "+s"(g_));
        tid = t_; lane = tid & 63; wave = __builtin_amdgcn_readfirstlane(tid >> 6); G = g_; gw = b_ * NWAVES + wave; ngw = G * NWAVES; }
};
#define IN_F(k) ((const float*)kin(KP, k))
#define WSP(type, off) ((type*)(kws(KP) + (off)))
#define P_x IN_F(0)
#define P_p IN_F(1)
#define P_pos ((const int*)kin(KP, 2))
#define P_attn_norm IN_F(3)
#define P_w_in IN_F(4)
#define P_out_norm_a IN_F(5)
#define P_out_norm_b IN_F(6)
#define P_w_out IN_F(7)
#define P_ffn_norm IN_F(8)
#define P_peer_wq IN_F(9)
#define P_peer_sk IN_F(10)
#define P_peer_u IN_F(11)
#define P_peer_v IN_F(12)
#define P_ple_norm IN_F(13)
#define P_ple_gate IN_F(14)
#define P_ple_proj IN_F(15)
#define P_final_norm IN_F(16)
#define P_Wt_in WSP(bf16, WS_WIN)
#define P_Wt_out WSP(bf16, WS_WOUT)
#define P_Wt_q WSP(bf16, WS_WQ)
#define P_Wt_g WSP(bf16, WS_WG)
#define P_Wt_p WSP(bf16, WS_WP)
#define P_ROPEC WSP(float, WS_ROPE)
#define P_ROPES (WSP(float, WS_ROPE) + SEQ * 64)
#define P_SSQ0 WSP(float, WS_SSQ)
#define P_SSQ1 (WSP(float, WS_SSQ) + (size_t)T * 32)
#define P_SSQ2 (WSP(float, WS_SSQ) + (size_t)T * 64)
#define P_IDS WSP(int, WS_IDS)
#define P_GATES WSP(float, WS_GATES)
#define P_PB WSP(bf16, WS_PB)
#define P_U8 WSP(unsigned char, WS_U)
#define P_V8 WSP(unsigned char, WS_V)
#define P_PART WSP(float, WS_PART)
#define P_AG WSP(float, WS_AG)
#define P_HBA WSP(bf16, WS_HBA)
#define P_HBB WSP(bf16, WS_HBB)
#define P_QKV WSP(bf16, WS_QKV)
#define P_OAP WSP(bf16, WS_OAP)
#define P_OBP WSP(bf16, WS_OBP)
#define P_VT16 WSP(bf16, WS_VT16)
#define P_VT1 WSP(bf16, WS_VT1)
#define P_LSE WSP(float, WS_LSE)
#define P_SKB WSP(bf16, WS_SKB)
#define P_H8 WSP(unsigned char, WS_H8)
#define P_WG8 WSP(unsigned char, WS_WG8)
#define P_HG8 WSP(unsigned char, WS_HG8)
#define P_KT16 WSP(bf16, WS_KT16)
#define P_KT1 WSP(bf16, WS_KT1)
#define P_MIX WSP(bf16, WS_MIX)
#define P_QR WSP(bf16, WS_QR)
#define P_PP WSP(bf16, WS_PP)

__device__ __forceinline__ float row_rstd(const float* ssq, int r) {
    const f32x4* sp = (const f32x4*)(ssq + (size_t)r * 32);
    f32x4 s = sp[0];
#pragma unroll
    for (int i = 1; i < 8; ++i) s += sp[i];
    return rsqrtf(((s[0] + s[1]) + (s[2] + s[3])) * (1.f / D) + EPS);
}
__device__ __forceinline__ float row_rstd4(const float* ssq, int r, int fq) {
    const f32x4* sp = (const f32x4*)(ssq + (size_t)r * 32) + 2 * fq;
    const f32x4 s = sp[0] + sp[1];
    float t = (s[0] + s[1]) + (s[2] + s[3]);
    t += __shfl_xor(t, 16); t += __shfl_xor(t, 32);
    return rsqrtf(t * (1.f / D) + EPS);
}
struct EpiInProj {
    static constexpr bool PERM = true, AFTER_DRAIN = false;
    int dummy;
    __device__ __forceinline__ void operator()(const pg8::f32x4 (&acc)[2][2][4][2], const pg8::Unit& u, int wr, int wc, int fr, int fq) const {
        const kptr_t KP = kargs();
        const float* ssq = P_SSQ0; bf16* O = P_QKV; const float* rc = P_ROPEC; const float* rs = P_ROPES; const int* pos = P_pos;
        const int row0 = u.pm * 256 + wr * 64 + fr, col0 = u.pn * 256 + wc * 32 + 8 * fq;
        const bool rope = u.pn < 8, isq = (u.pn < 4) || (u.pn >= 8 && u.pn < 12), isk = !isq;
        const float qs = isq ? 0.08838834764831845f : 1.f;
        const int j0 = 16 * wc + 4 * fq;
#pragma unroll
        for (int ai = 0; ai < 2; ++ai)
#pragma unroll
            for (int m = 0; m < 4; ++m) {
                const int r = row0 + ai * 128 + m * 16;
                const float rq = row_rstd4(ssq, r, fq) * qs;
                f32x4 c4 = (f32x4){1.f, 1.f, 1.f, 1.f}, s4 = (f32x4){0.f, 0.f, 0.f, 0.f};
                if (rope) { const int p = pos[r]; c4 = *(const f32x4*)(rc + (size_t)p * 64 + j0); s4 = *(const f32x4*)(rs + (size_t)p * 64 + j0); }
#pragma unroll
                for (int bj = 0; bj < 2; ++bj) {
                    const f32x4 v0 = acc[ai][bj][m][0] * rq, v1 = acc[ai][bj][m][1] * rq;
                    const f32x4 o0 = v0 * c4 - v1 * s4, o1 = v1 * c4 + v0 * s4;
                    v4u w; w.x = pg8::cvt_pk_bf16(o0[0], o0[1]); w.y = pg8::cvt_pk_bf16(o0[2], o0[3]); w.z = pg8::cvt_pk_bf16(o1[0], o1[1]); w.w = pg8::cvt_pk_bf16(o1[2], o1[3]);
                    if (!isk) *(v4u*)(O + (size_t)r * QW + col0 + bj * 128) = w;
                    else {
                        const int t = r & (SEQ - 1), bh = (r >> 12) * 8 + 2 * (u.pn & 3) + bj, ks = 2 * wc + (fq >> 1);
                        bf16* kd = (u.pn < 8) ? P_KT16 + ((((size_t)bh * 16 + (t & 15)) * 32 + (t >> 7)) * 8 + ks) * 128 + ((t >> 4) & 7) * 16
                                              : P_KT1 + (((size_t)bh * (SEQ / 8) + (t >> 3)) * 8 + ks) * 128 + (t & 7) * 16;
                        *(v4u*)(kd + 8 * (fq & 1)) = w;
                    }
                }
            }
    }
};
struct EpiVa {
    static constexpr bool PERM = true, AFTER_DRAIN = false;
    int dummy;
    __device__ __forceinline__ void operator()(const pg8::f32x4 (&acc)[2][2][4][2], const pg8::Unit& u, int wr, int wc, int fr, int fq) const {
        const kptr_t KP = kargs();
        const float* ssq = P_SSQ0; bf16* VT = P_VT16;
        const int row0 = u.pm * 256 + wr * 64 + fr;
        const int bh0 = (u.pm >> 4) * 8 + 2 * u.pn, chunk0 = (u.pm & 15) << 1;
#pragma unroll
        for (int ai = 0; ai < 2; ++ai) {
            float rstd[4];
#pragma unroll
            for (int m = 0; m < 4; ++m) rstd[m] = row_rstd4(ssq, row0 + ai * 128 + m * 16, fq);
#pragma unroll
            for (int bj = 0; bj < 2; ++bj)
#pragma unroll
                for (int n = 0; n < 2; ++n)
#pragma unroll
                    for (int i = 0; i < 4; ++i) {
                        const int dim = 32 * wc + 8 * fq + 4 * n + i;
                        v2u w; w.x = pg8::cvt_pk_bf16(acc[ai][bj][0][n][i] * rstd[0], acc[ai][bj][1][n][i] * rstd[1]);
                        w.y = pg8::cvt_pk_bf16(acc[ai][bj][2][n][i] * rstd[2], acc[ai][bj][3][n][i] * rstd[3]);
                        *(v2u*)(VT + ((((size_t)(bh0 + bj) * 16 + fr) * 32 + chunk0 + ai) * 128 + dim) * 8 + 4 * wr) = w;
                    }
        }
    }
};
struct EpiVbT {
    static constexpr bool PERM = true, AFTER_DRAIN = false;
    int dummy;
    __device__ __forceinline__ void operator()(const pg8::f32x4 (&acc)[2][2][4][2], const pg8::Unit& u, int wr, int wc, int fr, int fq) const {
        const kptr_t KP = kargs();
        const float* ssq = P_SSQ0; bf16* VT = P_VT1;
        const int row0 = u.pm * 256 + wr * 64 + fr, col0 = u.pn * 256 + wc * 32 + 8 * fq;
#pragma unroll
        for (int bj = 0; bj < 2; ++bj) {
            const int c = col0 + bj * 128, b = c >> 12, t = c & (SEQ - 1);
            float rs[8];
            { const f32x4* sp = (const f32x4*)(ssq + (size_t)(c + (fr & 7)) * 32) + 4 * (fr >> 3);
              const f32x4 s4 = (sp[0] + sp[1]) + (sp[2] + sp[3]);
              float tt = (s4[0] + s4[1]) + (s4[2] + s4[3]); tt += __shfl_xor(tt, 8);
              const float rv = rsqrtf(tt * (1.f / D) + EPS);
              const int lb_ = (fq << 4);
#pragma unroll
              for (int i = 0; i < 8; ++i) rs[i] = __shfl(rv, lb_ + i); }
#pragma unroll
            for (int ai = 0; ai < 2; ++ai)
#pragma unroll
                for (int m = 0; m < 4; ++m) {
                    const int r = row0 + ai * 128 + m * 16;
                    const f32x4 v0 = acc[ai][bj][m][0], v1 = acc[ai][bj][m][1];
                    v4u w; w.x = pg8::cvt_pk_bf16(v0[0] * rs[0], v0[1] * rs[1]); w.y = pg8::cvt_pk_bf16(v0[2] * rs[2], v0[3] * rs[3]);
                    w.z = pg8::cvt_pk_bf16(v1[0] * rs[4], v1[1] * rs[5]); w.w = pg8::cvt_pk_bf16(v1[2] * rs[6], v1[3] * rs[7]);
                    *(v4u*)(VT + (((size_t)(b * 8 + (r >> 7)) * (SEQ / 8) + (t >> 3)) * 128 + (r & 127)) * 8) = w;
                }
        }
    }
};
struct EpiBf16Scale {
    static constexpr bool PERM = true, AFTER_DRAIN = false;
    int which;
    __device__ __forceinline__ void operator()(const pg8::f32x4 (&acc)[2][2][4][2], const pg8::Unit& u, int wr, int wc, int fr, int fq) const {
        const kptr_t KP = kargs();
        bf16* O = which == 0 ? P_QR : P_PP; const int ldc = D; const float* ssq = which == 0 ? P_SSQ1 : nullptr;
        const int row0 = u.pm * 256 + wr * 64 + fr, col0 = u.pn * 256 + wc * 32 + 8 * fq;
#pragma unroll
        for (int ai = 0; ai < 2; ++ai)
#pragma unroll
            for (int m = 0; m < 4; ++m) {
                const int r = row0 + ai * 128 + m * 16;
                const float rstd = ssq ? row_rstd4(ssq, r, fq) : 1.f;
#pragma unroll
                for (int bj = 0; bj < 2; ++bj) {
                    const f32x4 o0 = acc[ai][bj][m][0] * rstd, o1 = acc[ai][bj][m][1] * rstd;
                    v4u w; w.x = pg8::cvt_pk_bf16(o0[0], o0[1]); w.y = pg8::cvt_pk_bf16(o0[2], o0[3]); w.z = pg8::cvt_pk_bf16(o1[0], o1[1]); w.w = pg8::cvt_pk_bf16(o1[2], o1[3]);
                    *(v4u*)(O + (size_t)r * ldc + col0 + bj * 128) = w;
                }
            }
    }
};
constexpr float XS4 = 1.0f;
template <int MODE> struct EpiResid {
    static constexpr bool PERM = true, AFTER_DRAIN = false;
    int dummy;
    __device__ __forceinline__ void operator()(const pg8::f32x4 (&acc)[2][2][4][2], const pg8::Unit& u, int wr, int wc, int fr, int fq) const {
        const kptr_t KP = kargs();
        const bf16* HI = MODE == 0 ? P_HBB : P_HBA; bf16* HO = MODE == 0 ? P_HBA : P_HBB; float* ssq_out = MODE == 0 ? P_SSQ1 : P_SSQ0; const float* ssq_in = P_SSQ2; const bf16* PP = P_PP;
        const int row0 = u.pm * 256 + wr * 64 + fr, col0 = u.pn * 256 + wc * 32 + 8 * fq;
#pragma unroll
        for (int ai = 0; ai < 2; ++ai)
#pragma unroll
            for (int m = 0; m < 4; ++m) {
                const int r = row0 + ai * 128 + m * 16;
                float rstd = 1.f; if (MODE == 1) rstd = row_rstd4(ssq_in, r, fq);
                float ss = 0.f;
#pragma unroll
                for (int bj = 0; bj < 2; ++bj) {
                    const size_t off = (size_t)r * D + col0 + bj * 128;
                    const v4u hw = *(const v4u*)(HI + off);
                    f32x4 a0 = acc[ai][bj][m][0], a1 = acc[ai][bj][m][1];
                    if (MODE == 1) {
                        const v4u pw = *(const v4u*)(PP + off);
                        const f32x4 p0 = (f32x4){bflo(pw.x), bfhi(pw.x), bflo(pw.y), bfhi(pw.y)}, p1 = (f32x4){bflo(pw.z), bfhi(pw.z), bflo(pw.w), bfhi(pw.w)};
#pragma unroll
                        for (int i = 0; i < 4; ++i) { a0[i] = p0[i] * __builtin_amdgcn_rcpf(1.f + __expf(-a0[i] * rstd)); a1[i] = p1[i] * __builtin_amdgcn_rcpf(1.f + __expf(-a1[i] * rstd)); }
                    }
                    const f32x4 h0 = (f32x4){bflo(hw.x), bfhi(hw.x), bflo(hw.y), bfhi(hw.y)} + a0, h1 = (f32x4){bflo(hw.z), bfhi(hw.z), bflo(hw.w), bfhi(hw.w)} + a1;
                    v4u ow; ow.x = pg8::cvt_pk_bf16(h0[0], h0[1]); ow.y = pg8::cvt_pk_bf16(h0[2], h0[3]); ow.z = pg8::cvt_pk_bf16(h1[0], h1[1]); ow.w = pg8::cvt_pk_bf16(h1[2], h1[3]);
                    *(v4u*)(HO + off) = ow;
                    const f32x4 q0 = (f32x4){bflo(ow.x), bfhi(ow.x), bflo(ow.y), bfhi(ow.y)}, q1 = (f32x4){bflo(ow.z), bfhi(ow.z), bflo(ow.w), bfhi(ow.w)};
                    if (MODE == 0) {
                        unsigned w4 = 0u;
                        w4 = __builtin_amdgcn_cvt_scalef32_pk_fp4_f32(w4, q0[0] * XS4, q0[1] * XS4, 1.0f, 0); w4 = __builtin_amdgcn_cvt_scalef32_pk_fp4_f32(w4, q0[2] * XS4, q0[3] * XS4, 1.0f, 1);
                        w4 = __builtin_amdgcn_cvt_scalef32_pk_fp4_f32(w4, q1[0] * XS4, q1[1] * XS4, 1.0f, 2); w4 = __builtin_amdgcn_cvt_scalef32_pk_fp4_f32(w4, q1[2] * XS4, q1[3] * XS4, 1.0f, 3);
                        *(unsigned*)(P_H8 + (off >> 1)) = w4; }
                    ss += ((q0[0] * q0[0] + q0[1] * q0[1]) + (q0[2] * q0[2] + q0[3] * q0[3])) + ((q1[0] * q1[0] + q1[1] * q1[1]) + (q1[2] * q1[2] + q1[3] * q1[3]));
                }
                ss += __shfl_xor(ss, 16); ss += __shfl_xor(ss, 32);
                if (fq == 0) ssq_out[(size_t)r * 32 + u.pn * 4 + wc] = ss;
            }
    }
};
struct EpiNull { static constexpr bool PERM = true, AFTER_DRAIN = false; int dummy;
    __device__ __forceinline__ void operator()(const pg8::f32x4 (&acc)[2][2][4][2], const pg8::Unit& u, int wr, int wc, int fr, int fq) const {
        float s = 0.f;
#pragma unroll
        for (int ai = 0; ai < 2; ++ai)
#pragma unroll
            for (int bj = 0; bj < 2; ++bj)
#pragma unroll
                for (int m = 0; m < 4; ++m)
#pragma unroll
                    for (int n = 0; n < 2; ++n) s += acc[ai][bj][m][n][0] + acc[ai][bj][m][n][1] + acc[ai][bj][m][n][2] + acc[ai][bj][m][n][3];
        if (s == 1.2345e-30f) { const kptr_t KP = kargs(); P_LSE[0] = s; }
    }
};
__device__ __forceinline__ int inproj_src_col(int c) {
    if (c >= 5120) return c;
    if (c >= 4096) return c - 2048;
    if (c >= 2048) return c + 1024;
    const int head = c >> 7, p = c & 127, wc = p >> 5, fq = (p >> 3) & 3, n = (p >> 2) & 1, i = p & 3;
    return head * 128 + 64 * n + 16 * wc + 4 * fq + i;
}
typedef short v2s_t __attribute__((ext_vector_type(2)));
__device__ __forceinline__ void transpose_item(const float* W, int K, int N, bf16* WT, const float* gain, bool perm, LAS float* scr, int item, int lane, unsigned char* W8 = nullptr) {
    const int nblk = N / 32, kb = item / nblk, nb = item % nblk, k0 = 64 * kb, n0 = 32 * nb;
    const int cs = perm ? inproj_src_col(n0 + (lane & 31)) : n0 + (lane & 31);
    float vals[32];
#pragma unroll
    for (int i = 0; i < 32; ++i) { const int kk = 2 * i + (lane >> 5); const float g = gain ? gain[k0 + kk] : 1.f; vals[i] = W[(size_t)(k0 + kk) * N + cs] * g; }
#pragma unroll
    for (int i = 0; i < 32; ++i) scr[(2 * i + (lane >> 5)) * 33 + (lane & 31)] = vals[i];
    LDS_WAIT(); asm volatile("" ::: "memory");
    const int c = lane & 7;
#pragma unroll
    for (int j = 0; j < 4; ++j) { const int n = (lane >> 3) + 8 * j; const LAS float* s = scr + (8 * c) * 33 + n;
        v4u o; o.x = pk2(s[0 * 33], s[1 * 33]); o.y = pk2(s[2 * 33], s[3 * 33]); o.z = pk2(s[4 * 33], s[5 * 33]); o.w = pk2(s[6 * 33], s[7 * 33]);
        if (!W8) *(v4u*)(WT + (size_t)(n0 + n) * K + k0 + 8 * c) = o;
        if (W8) {
            v2s_t w0 = (v2s_t){0, 0}, w1 = (v2s_t){0, 0};
            w0 = __builtin_amdgcn_cvt_scalef32_pk_fp8_f32(w0, s[0 * 33] * 64.f, s[1 * 33] * 64.f, 1.0f, false); w0 = __builtin_amdgcn_cvt_scalef32_pk_fp8_f32(w0, s[2 * 33] * 64.f, s[3 * 33] * 64.f, 1.0f, true);
            w1 = __builtin_amdgcn_cvt_scalef32_pk_fp8_f32(w1, s[4 * 33] * 64.f, s[5 * 33] * 64.f, 1.0f, false); w1 = __builtin_amdgcn_cvt_scalef32_pk_fp8_f32(w1, s[6 * 33] * 64.f, s[7 * 33] * 64.f, 1.0f, true);
            *(v2u*)(W8 + (size_t)(n0 + n) * K + k0 + 8 * c) = (v2u){__builtin_bit_cast(unsigned, w0), __builtin_bit_cast(unsigned, w1)}; } }
    LDS_WAIT(); asm volatile("" ::: "memory");
}
constexpr float USCALE = 88.f, VSCALE = 5.5f;
__device__ __forceinline__ void p_prologue(LAS unsigned char* lds_) {
    Frame F; F.init(lds_); const kptr_t KP = kargs();
    LAS float* scr = (LAS float*)(F.lds + F.wave * 16384);
    constexpr int I_IN = (D / 64) * (INW / 32), I_SQ = (D / 64) * (D / 32), I_P = (PLE / 64) * (D / 32);
    constexpr int PER_LAYER = I_IN + 3 * I_SQ + I_P;
    for (int it = F.gw; it < DEPTH * PER_LAYER; it += F.ngw) {
        const int l = it / PER_LAYER; int r = it % PER_LAYER;
        if (r < I_IN) { transpose_item(P_w_in + (size_t)l * D * INW, D, INW, P_Wt_in + (size_t)l * INW * D, P_attn_norm + l * D, true, scr, r, F.lane); continue; } r -= I_IN;
        if (r < I_SQ) {
            const int kb = r / (D / 32), k0 = 64 * kb;
            const float* g = (k0 < WA) ? (P_out_norm_a + l * WA) : (P_out_norm_b + l * WA - WA);
            transpose_item(P_w_out + (size_t)l * D * D, D, D, P_Wt_out + (size_t)l * D * D, g, false, scr, r, F.lane); continue; } r -= I_SQ;
        if (r < I_SQ) { transpose_item(P_peer_wq + (size_t)l * D * D, D, D, P_Wt_q + (size_t)l * D * D, P_ffn_norm + l * D, false, scr, r, F.lane); continue; } r -= I_SQ;
        if (r < I_SQ) { transpose_item(P_ple_gate + (size_t)l * D * D, D, D, P_Wt_g + (size_t)l * D * D, P_ple_norm + l * D, false, scr, r, F.lane, P_WG8 + (size_t)l * D * D); continue; } r -= I_SQ;
        transpose_item(P_ple_proj + (size_t)l * PLE * D, PLE, D, P_Wt_p + (size_t)l * D * PLE, nullptr, false, scr, r, F.lane);
    }
    const size_t gt = (size_t)blockIdx.x * NTHREADS + F.tid, ngt = (size_t)F.G * NTHREADS;
    for (size_t i0 = gt; i0 < (size_t)DEPTH * NEXP * D / 8; i0 += 4 * ngt) {
        f32x4 ua[4], ub[4], va[4], vb[4]; size_t e0[4];
#pragma unroll
        for (int q = 0; q < 4; ++q) { const size_t i = (i0 + q * ngt < (size_t)DEPTH * NEXP * D / 8) ? i0 + q * ngt : i0; e0[q] = i * 8;
            ua[q] = *(const f32x4*)(P_peer_u + e0[q]); ub[q] = *(const f32x4*)(P_peer_u + e0[q] + 4); va[q] = *(const f32x4*)(P_peer_v + e0[q]); vb[q] = *(const f32x4*)(P_peer_v + e0[q] + 4); }
#pragma unroll
        for (int q = 0; q < 4; ++q) {
            const int l = (int)(e0[q] / ((size_t)NEXP * D)), d0 = (int)(e0[q] % D);
            const f32x4 ga = *(const f32x4*)(P_ffn_norm + l * D + d0) * USCALE, gb = *(const f32x4*)(P_ffn_norm + l * D + d0 + 4) * USCALE;
            const f32x4 a = ua[q], b = ub[q];
            const size_t sv = ((size_t)(l * 8 + (d0 >> 8)) * NEXP + (e0[q] / D) % NEXP) * 128 + ((d0 & 255) >> 1);
            unsigned uo = 0u;
            uo = __builtin_amdgcn_cvt_scalef32_pk_fp4_f32(uo, a[0] * ga[0], a[1] * ga[1], 1.0f, 0); uo = __builtin_amdgcn_cvt_scalef32_pk_fp4_f32(uo, a[2] * ga[2], a[3] * ga[3], 1.0f, 1);
            uo = __builtin_amdgcn_cvt_scalef32_pk_fp4_f32(uo, b[0] * gb[0], b[1] * gb[1], 1.0f, 2); uo = __builtin_amdgcn_cvt_scalef32_pk_fp4_f32(uo, b[2] * gb[2], b[3] * gb[3], 1.0f, 3);
            *(unsigned*)(P_U8 + sv) = uo;
            const f32x4 c = va[q] * VSCALE, d = vb[q] * VSCALE;
            unsigned qq = 0u;
            qq = __builtin_amdgcn_cvt_scalef32_pk_fp4_f32(qq, c[0], c[1], 1.0f, 0); qq = __builtin_amdgcn_cvt_scalef32_pk_fp4_f32(qq, c[2], c[3], 1.0f, 1);
            qq = __builtin_amdgcn_cvt_scalef32_pk_fp4_f32(qq, d[0], d[1], 1.0f, 2); qq = __builtin_amdgcn_cvt_scalef32_pk_fp4_f32(qq, d[2], d[3], 1.0f, 3);
            *(unsigned*)(P_V8 + sv) = qq;
        }
    }
    for (size_t i = gt; i < (size_t)DEPTH * PH * 2 * NKEYS * 128 / 8; i += ngt) {
        const size_t e0 = i * 8;
        const f32x4 a = *(const f32x4*)(P_peer_sk + e0), b = *(const f32x4*)(P_peer_sk + e0 + 4);
        v4u o; o.x = pk2(a[0], a[1]); o.y = pk2(a[2], a[3]); o.z = pk2(b[0], b[1]); o.w = pk2(b[2], b[3]);
        *(v4u*)(P_SKB + e0) = o;
    }
    for (size_t i0 = gt; i0 < (size_t)DEPTH * T * PLE / 8; i0 += 4 * ngt) {
        f32x4 a[4], b[4]; size_t e0[4];
#pragma unroll
        for (int q = 0; q < 4; ++q) { const size_t i = (i0 + q * ngt < (size_t)DEPTH * T * PLE / 8) ? i0 + q * ngt : i0; e0[q] = i * 8; a[q] = *(const f32x4*)(P_p + e0[q]); b[q] = *(const f32x4*)(P_p + e0[q] + 4); }
#pragma unroll
        for (int q = 0; q < 4; ++q) { v4u o; o.x = pk2(a[q][0], a[q][1]); o.y = pk2(a[q][2], a[q][3]); o.z = pk2(b[q][0], b[q][1]); o.w = pk2(b[q][2], b[q][3]);
            *(v4u*)(P_PB + e0[q]) = o; }
    }
    for (size_t i = gt; i < (size_t)SEQ * 64; i += ngt) {
        const int pos = (int)(i >> 6), j = (int)(i & 63);
        const float inv = powf(10000.f, -(float)j / 64.f);
        const float ang = (float)pos * inv;
        const double rev = (double)ang * 0.15915494309189535;
        const float fr = (float)(rev - rint(rev));
        P_ROPEC[i] = __builtin_amdgcn_cosf(fr); P_ROPES[i] = __builtin_amdgcn_sinf(fr);
    }
    if (blockIdx.x == 0 && F.tid < 256) ((unsigned*)(kws(KP) + WS_VT16 - 1024))[F.tid] = 0u;
    for (int t = F.gw; t < T; t += F.ngw) {
        const f32x4* xr = (const f32x4*)(P_x + (size_t)t * D) + F.lane * 2;
        float ss = 0.f;
#pragma unroll
        for (int j = 0; j < 4; ++j) {
            const f32x4 a = xr[j * 128], b = xr[j * 128 + 1];
            const size_t off = (size_t)t * D + j * 512 + F.lane * 8;
            v4u o; o.x = pk2(a[0], a[1]); o.y = pk2(a[2], a[3]); o.z = pk2(b[0], b[1]); o.w = pk2(b[2], b[3]);
            *(v4u*)(P_HBB + off) = o;
            ss += (a[0] * a[0] + a[1] * a[1]) + (a[2] * a[2] + a[3] * a[3]) + (b[0] * b[0] + b[1] * b[1]) + (b[2] * b[2] + b[3] * b[3]);
        }
        ss = wave_sum(ss);
        if (F.lane < 32) P_SSQ0[(size_t)t * 32 + F.lane] = (F.lane == 0) ? ss : 0.f;
    }
}

typedef short bf16x8 __attribute__((ext_vector_type(8)));
typedef short bf16x8u __attribute__((ext_vector_type(8), aligned(4)));
typedef float f32x16 __attribute__((ext_vector_type(16)));
#define MFMA32(a, b, c) __builtin_amdgcn_mfma_f32_32x32x16_bf16((a), (b), (c), 0, 0, 0)
constexpr int OT_ROW = 272, OT_BYTES = 32 * OT_ROW;
__device__ __forceinline__ int keymap(int r) { return (r & 0x13) | ((r & 8) >> 1) | ((r & 4) << 1); }
__device__ __forceinline__ bf16x8 pack8(const float* p) { v4u w; w.x = pg8::cvt_pk_bf16(p[0], p[1]); w.y = pg8::cvt_pk_bf16(p[2], p[3]); w.z = pg8::cvt_pk_bf16(p[4], p[5]); w.w = pg8::cvt_pk_bf16(p[6], p[7]); return __builtin_bit_cast(bf16x8, w); }
__device__ __forceinline__ void chunk_of(int pat, int j, int q, int P0, int r, int gi, int& cls, int& ps) {
    if (pat == 0) { const int cidx = 4 * j + q; cls = cidx >> 1; ps = (P0 & ~7) + 8 * (cidx & 1); }
    else {
        const int A = gi - (gi - j + 5) % 5;
        if (pat == 1) { cls = 4 * q + r; ps = 8 * A; } else { cls = r; ps = 32 * A + 8 * q; }
    }
}
__device__ __forceinline__ void p_attn_dilated(LAS unsigned char* lds_) {
    Frame F; F.init(lds_); const kptr_t KP = kargs();
    const bf16* QKV = P_QKV; const bf16* VT = P_VT16; const bf16* KT = P_KT16; bf16* OAP = P_OAP; float* LSE = P_LSE;
    const int n = F.lane & 31, hh = F.lane >> 5, kap = keymap(n);
#if defined(PROBE_DILH1)
    if (F.wave >= 4) return;
    for (int item = (F.gw / NWAVES) * 4 + F.wave; item < BATCH * NH * 3 * 128; item += F.G * 4) {
#elif defined(PROBE_DILH2)
    if (F.wave & 2) return;
    for (int item = (F.gw / NWAVES) * 4 + (F.wave & 1) + 2 * (F.wave >> 2); item < BATCH * NH * 3 * 128; item += F.G * 4) {
#else
    for (int item = F.gw; item < BATCH * NH * 3 * 128; item += F.ngw) {
#endif
        const int g = item & 127, pat = (item >> 7) % 3, bh = item / 384, h = bh & 7, b = bh >> 3;
        int d, qbase, ntiles, r = 0, P0, gi = 0;
        if (pat == 0) { d = 1; qbase = 32 * g; ntiles = 8; P0 = 2 * g - 8; }
        else if (pat == 1) { d = 4; r = g >> 5; gi = g & 31; qbase = 128 * gi + r; ntiles = 5; P0 = 8 * gi - 32; }
        else { d = 16; r = g >> 3; gi = g & 7; qbase = 512 * gi + r; ntiles = 5; P0 = 32 * gi - 128; }
        const int tq = qbase + n * d;
        bf16x8 qf[8];
        { const bf16* qp = QKV + (size_t)(b * SEQ + tq) * QW + h * HD + 8 * hh;
#pragma unroll
          for (int s = 0; s < 8; ++s) qf[s] = *(const bf16x8*)(qp + 16 * s); }
        f32x16 o[4];
#pragma unroll
        for (int dt = 0; dt < 4; ++dt)
#pragma unroll
            for (int i = 0; i < 16; ++i) o[dt][i] = 0.f;
        float m = -3.0e38f, l = 0.f;
        bf16x8 kn[8];
#define DA_KLOAD(j_) do { int cls_, ps_; chunk_of(pat, (j_), kap >> 3, P0, r, gi, cls_, ps_); \
            const bf16* kp_ = KT + ((((size_t)bh * 16 + cls_) * 32 + (max(ps_, 0) >> 3)) * 8) * 128 + (kap & 7) * 16 + 8 * hh; \
            _Pragma("unroll") for (int s_ = 0; s_ < 8; ++s_) kn[s_] = *(const bf16x8*)(kp_ + 128 * s_); } while (0)
        DA_KLOAD(0);
        for (int j = 0; j < ntiles; ++j) {
            if (pat != 0 && gi - (gi - j + 5) % 5 < 0) { if (j + 1 < ntiles) DA_KLOAD(j + 1); continue; }
            int ccls[2], cps[2];
            chunk_of(pat, j, hh, P0, r, gi, ccls[0], cps[0]); chunk_of(pat, j, 2 + hh, P0, r, gi, ccls[1], cps[1]);
            bf16x8 vf[2][4];
#define DA_VLOAD(sp_) do { const bf16* vp_ = VT + ((((size_t)bh * 16 + ccls[sp_]) * 32 + (max(cps[sp_], 0) >> 3)) * 128 + n) * 8; \
            _Pragma("unroll") for (int dt_ = 0; dt_ < 4; ++dt_) vf[sp_][dt_] = *(const bf16x8*)(vp_ + dt_ * 32 * 8); } while (0)
            DA_VLOAD(0);
            f32x16 S;
#pragma unroll
            for (int i = 0; i < 16; ++i) S[i] = 0.f;
#pragma unroll
            for (int s = 0; s < 8; ++s) S = MFMA32(kn[s], qf[s], S);
            asm volatile("" ::: "memory");
            DA_VLOAD(1);
            if (j + 1 < ntiles) DA_KLOAD(j + 1);
            float pv[16]; float tmax = -3.0e38f;
#pragma unroll
            for (int i = 0; i < 16; ++i) { const int sp = i >> 3, pos = cps[sp] + (i & 7), tk = 16 * pos + ccls[sp];
                const bool ok = (pos >= 0) && (tk <= tq) && (tq - tk <= 128 * d);
                pv[i] = ok ? S[i] : -3.0e38f; tmax = fmaxf(tmax, pv[i]); }
            tmax = fmaxf(tmax, __shfl_xor(tmax, 32));
            if (__any(tmax > m + 8.f)) {
                const float mn = fmaxf(m, tmax), alpha = __expf(m - mn);
                l *= alpha; m = mn;
#pragma unroll
                for (int dt = 0; dt < 4; ++dt)
#pragma unroll
                    for (int i = 0; i < 16; ++i) o[dt][i] *= alpha;
            }
            float ps_ = 0.f;
#pragma unroll
            for (int i = 0; i < 16; ++i) { pv[i] = (pv[i] > -1.0e38f) ? __expf(pv[i] - m) : 0.f; ps_ += pv[i]; }
            l += ps_;
#pragma unroll
            for (int sp = 0; sp < 2; ++sp) {
                const bf16x8 pf = pack8(pv + 8 * sp);
#pragma unroll
                for (int dt = 0; dt < 4; ++dt) o[dt] = MFMA32(vf[sp][dt], pf, o[dt]);
            }
        }
#undef DA_KLOAD
#undef DA_VLOAD
        const float lt = l + __shfl_xor(l, 32), il = 1.f / lt;
        { LAS unsigned char* st = F.lds + F.wave * OT_BYTES;
#pragma unroll
          for (int dt = 0; dt < 4; ++dt)
#pragma unroll
              for (int q4 = 0; q4 < 4; ++q4) { v2u ww; ww.x = pk2(o[dt][4 * q4] * il, o[dt][4 * q4 + 1] * il); ww.y = pk2(o[dt][4 * q4 + 2] * il, o[dt][4 * q4 + 3] * il);
                  *(LAS v2u*)(st + n * OT_ROW + (32 * dt + 8 * q4 + 4 * hh) * 2) = ww; }
#pragma unroll
          for (int k = 0; k < 8; ++k) { const int row = 4 * k + (F.lane >> 4);
              const v4u x = *(const LAS v4u*)(st + row * OT_ROW + (F.lane & 15) * 16);
              *(v4u*)(OAP + ((size_t)pat * T + b * SEQ + qbase + row * d) * WA + h * HD + (F.lane & 15) * 8) = x; } }
        if (hh == 0) LSE[((size_t)pat * T + b * SEQ + tq) * 8 + h] = m + __logf(lt);
    }
}
#ifndef STK_THR
#define STK_THR -17.5f
#endif
__device__ __forceinline__ void p_attn_stick(LAS unsigned char* lds_) {
    Frame F; F.init(lds_); const kptr_t KP = kargs();
    const bf16* QKV = P_QKV; const bf16* VT = P_VT1; const bf16* KT = P_KT1; bf16* OBP = P_OBP;
    const int n = F.lane & 31, hh = F.lane >> 5, kap = keymap(n);
    for (int item = F.gw; item < BATCH * NH * 128; item += F.ngw) {
        const int qb = item & 127, bh = item >> 7, h = bh & 7, b = bh >> 3, q0 = 32 * qb, tq = q0 + n;
        bf16x8 qf[8];
        { const bf16* qp = QKV + (size_t)(b * SEQ + tq) * QW + 2048 + h * HD + 8 * hh;
#pragma unroll
          for (int s = 0; s < 8; ++s) qf[s] = *(const bf16x8*)(qp + 16 * s); }
        f32x16 o[4];
#pragma unroll
        for (int dt = 0; dt < 4; ++dt)
#pragma unroll
            for (int i = 0; i < 16; ++i) o[dt][i] = 0.f;
        float carry = 0.f;
        bf16x8 kn[8];
        { const bf16* kp = KT + (((size_t)bh * (SEQ / 8) + ((q0 + kap) >> 3)) * 8) * 128 + (kap & 7) * 16 + 8 * hh;
#pragma unroll
          for (int s = 0; s < 8; ++s) kn[s] = *(const bf16x8*)(kp + 128 * s); }
        for (int kb = q0; kb >= 0; kb -= 32) {
            bf16x8 vf[2][4];
#define SB_VLOAD(sp_) do { const bf16* vp_ = VT + (((size_t)bh * (SEQ / 8) + ((kb + 16 * (sp_) + 8 * hh) >> 3)) * 128 + n) * 8; \
            _Pragma("unroll") for (int dt_ = 0; dt_ < 4; ++dt_) vf[sp_][dt_] = *(const bf16x8*)(vp_ + dt_ * 32 * 8); } while (0)
            SB_VLOAD(0);
            f32x16 S;
#pragma unroll
            for (int i = 0; i < 16; ++i) S[i] = 0.f;
#pragma unroll
            for (int s = 0; s < 8; ++s) S = MFMA32(kn[s], qf[s], S);
            asm volatile("" ::: "memory");
            SB_VLOAD(1);
            { const bf16* kp = KT + (((size_t)bh * (SEQ / 8) + ((max(kb - 32, 0) + kap) >> 3)) * 8) * 128 + (kap & 7) * 16 + 8 * hh;
#pragma unroll
                for (int s = 0; s < 8; ++s) kn[s] = *(const bf16x8*)(kp + 128 * s); }
            float lm[16], av[16]; float B0 = 0.f, B1 = 0.f;
#pragma unroll
            for (int i = 0; i < 16; ++i) { const int tk = kb + 16 * (i >> 3) + 8 * hh + (i & 7); const float z = S[i];
                lm[i] = (tk < tq) ? -(fmaxf(z, 0.f) + __logf(1.f + __expf(-fabsf(z)))) : 0.f;
                if (i < 8) B0 += lm[i]; else B1 += lm[i]; }
            const float PB0 = __shfl_xor(B0, 32), PB1 = __shfl_xor(B1, 32);
            const float base1 = hh ? 0.f : PB1, base0 = hh ? (B1 + PB1) : (PB1 + B1 + PB0);
            float run = 0.f;
#pragma unroll
            for (int e = 7; e >= 0; --e) { const int i = 8 + e; const int tk = kb + 16 + 8 * hh + e;
                av[i] = (tk < tq) ? __expf(S[i] + lm[i] + (carry + base1 + run)) : 0.f; run += lm[i]; }
            run = 0.f;
#pragma unroll
            for (int e = 7; e >= 0; --e) { const int i = e; const int tk = kb + 8 * hh + e;
                av[i] = (tk < tq) ? __expf(S[i] + lm[i] + (carry + base0 + run)) : 0.f; run += lm[i]; }
            carry += (B0 + B1) + (PB0 + PB1);
#pragma unroll
            for (int sp = 0; sp < 2; ++sp) {
                const bf16x8 pf = pack8(av + 8 * sp);
#pragma unroll
                for (int dt = 0; dt < 4; ++dt) o[dt] = MFMA32(vf[sp][dt], pf, o[dt]);
            }
            if (__all(carry < STK_THR)) break;
        }
        { LAS unsigned char* st = F.lds + F.wave * OT_BYTES;
#pragma unroll
          for (int dt = 0; dt < 4; ++dt)
#pragma unroll
              for (int q4 = 0; q4 < 4; ++q4) { v2u w; w.x = pk2(o[dt][4 * q4], o[dt][4 * q4 + 1]); w.y = pk2(o[dt][4 * q4 + 2], o[dt][4 * q4 + 3]);
                  *(LAS v2u*)(st + n * OT_ROW + (32 * dt + 8 * q4 + 4 * hh) * 2) = w; }
#pragma unroll
          for (int k = 0; k < 8; ++k) { const int row = 4 * k + (F.lane >> 4);
              const v4u x = *(const LAS v4u*)(st + row * OT_ROW + (F.lane & 15) * 16);
              *(v4u*)(OBP + (size_t)(b * SEQ + q0 + row) * WA + h * HD + (F.lane & 15) * 8) = x; } }
    }
}
__device__ __forceinline__ void p_combine(LAS unsigned char* lds_) {
    Frame F; F.init(lds_); const kptr_t KP = kargs();
    const bf16* OAP = P_OAP; const bf16* OBP = P_OBP; const float* LSE = P_LSE; bf16* MIX = P_MIX;
    const int hd = F.lane >> 3, c0 = F.lane * 16;
    for (int tb = F.gw; tb < T; tb += 2 * F.ngw) {
        v4u ra[2][3][2], rb[2][2]; float ls[2][3];
#pragma unroll
        for (int q = 0; q < 2; ++q) { const int t = (tb + q * F.ngw < T) ? tb + q * F.ngw : tb;
#pragma unroll
            for (int p = 0; p < 3; ++p) { const v4u* sp = (const v4u*)(OAP + ((size_t)p * T + t) * WA + c0); ra[q][p][0] = sp[0]; ra[q][p][1] = sp[1]; ls[q][p] = LSE[((size_t)p * T + t) * 8 + hd]; }
            const v4u* sb = (const v4u*)(OBP + (size_t)t * WA + c0); rb[q][0] = sb[0]; rb[q][1] = sb[1]; }
#pragma unroll
        for (int q = 0; q < 2; ++q) {
            const int t = tb + q * F.ngw;
            const float l0 = ls[q][0], l1 = ls[q][1], l2 = ls[q][2];
            const float mx = fmaxf(l0, fmaxf(l1, l2)), e0 = __expf(l0 - mx), e1 = __expf(l1 - mx), e2 = __expf(l2 - mx), inv = 1.f / (e0 + e1 + e2);
            const float w[3] = {e0 * inv, e1 * inv, e2 * inv};
            float oa[16];
#pragma unroll
            for (int i = 0; i < 16; ++i) oa[i] = 0.f;
#pragma unroll
            for (int p = 0; p < 3; ++p) {
                const v4u a = ra[q][p][0], c = ra[q][p][1];
                const unsigned ww[8] = {a.x, a.y, a.z, a.w, c.x, c.y, c.z, c.w};
#pragma unroll
                for (int i = 0; i < 8; ++i) { oa[2 * i] += w[p] * bflo(ww[i]); oa[2 * i + 1] += w[p] * bfhi(ww[i]); }
            }
            float ob[16];
            { const v4u a = rb[q][0], c = rb[q][1];
              const unsigned ww[8] = {a.x, a.y, a.z, a.w, c.x, c.y, c.z, c.w};
#pragma unroll
              for (int i = 0; i < 8; ++i) { ob[2 * i] = bflo(ww[i]); ob[2 * i + 1] = bfhi(ww[i]); } }
            float sa = 0.f, sb = 0.f;
#pragma unroll
            for (int i = 0; i < 16; ++i) { sa += oa[i] * oa[i]; sb += ob[i] * ob[i]; }
            const float ra_ = rsqrtf(wave_sum(sa) * (1.f / WA) + EPS), rb_ = rsqrtf(wave_sum(sb) * (1.f / WA) + EPS);
            v4u x0, x1, y0, y1;
            x0.x = pk2(oa[0] * ra_, oa[1] * ra_); x0.y = pk2(oa[2] * ra_, oa[3] * ra_); x0.z = pk2(oa[4] * ra_, oa[5] * ra_); x0.w = pk2(oa[6] * ra_, oa[7] * ra_);
            x1.x = pk2(oa[8] * ra_, oa[9] * ra_); x1.y = pk2(oa[10] * ra_, oa[11] * ra_); x1.z = pk2(oa[12] * ra_, oa[13] * ra_); x1.w = pk2(oa[14] * ra_, oa[15] * ra_);
            y0.x = pk2(ob[0] * rb_, ob[1] * rb_); y0.y = pk2(ob[2] * rb_, ob[3] * rb_); y0.z = pk2(ob[4] * rb_, ob[5] * rb_); y0.w = pk2(ob[6] * rb_, ob[7] * rb_);
            y1.x = pk2(ob[8] * rb_, ob[9] * rb_); y1.y = pk2(ob[10] * rb_, ob[11] * rb_); y1.z = pk2(ob[12] * rb_, ob[13] * rb_); y1.w = pk2(ob[14] * rb_, ob[15] * rb_);
            if (t < T) { v4u* dA = (v4u*)(MIX + (size_t)t * D + c0); dA[0] = x0; dA[1] = x1;
                         v4u* dB = (v4u*)(MIX + (size_t)t * D + WA + c0); dB[0] = y0; dB[1] = y1; }
        }
    }
}

__device__ __forceinline__ unsigned f2sort(float f) { const unsigned u = __builtin_bit_cast(unsigned, f); return (u & 0x80000000u) ? ~u : (u | 0x80000000u); }
__device__ __forceinline__ float sort2f(unsigned k) { const unsigned u = (k & 0x80000000u) ? (k & 0x7fffffffu) : ~k; return __builtin_bit_cast(float, u); }
__device__ __forceinline__ unsigned umax(unsigned a, unsigned b) { return a > b ? a : b; }
__device__ __forceinline__ unsigned umin(unsigned a, unsigned b) { return a < b ? a : b; }
#define CE_DESC(x, y) do { const unsigned hi_ = umax(x, y), lo_ = umin(x, y); x = hi_; y = lo_; } while (0)
#define CE_ASC(x, y) do { const unsigned hi_ = umax(x, y), lo_ = umin(x, y); x = lo_; y = hi_; } while (0)
__device__ __forceinline__ void sort16_desc(unsigned (&a)[64], const int base) {
#pragma unroll
    for (int k = 2; k <= 16; k <<= 1)
#pragma unroll
        for (int j = k >> 1; j >= 1; j >>= 1)
#pragma unroll
            for (int i = 0; i < 16; ++i) { const int l = i ^ j; if (l > i) { if ((i & k) == 0) CE_DESC(a[base + i], a[base + l]); else CE_ASC(a[base + i], a[base + l]); } }
}
__device__ __forceinline__ void merge_top16(const unsigned* A, const unsigned* B, unsigned (&c)[16]) {
#pragma unroll
    for (int i = 0; i < 16; ++i) c[i] = umax(A[i], B[15 - i]);
#pragma unroll
    for (int st = 8; st >= 1; st >>= 1)
#pragma unroll
        for (int i = 0; i < 16; ++i) if ((i & st) == 0) CE_DESC(c[i], c[i + st]);
}
__device__ __forceinline__ void top16_of64(unsigned (&keys)[64], unsigned (&res)[16]) {
    sort16_desc(keys, 0); sort16_desc(keys, 16); sort16_desc(keys, 32); sort16_desc(keys, 48);
    unsigned X[16], Y[16];
    merge_top16(keys, keys + 16, X); merge_top16(keys + 32, keys + 48, Y); merge_top16(X, Y, res);
}
__device__ __forceinline__ unsigned sel4(unsigned w0, unsigned w1, unsigned w2, unsigned w3, int a) {
    const unsigned lo = (a & 4) ? w1 : w0, hi = (a & 4) ? w3 : w2, x = (a & 8) ? hi : lo;
    return (x >> (8 * (a & 3))) & 0xffu;
}
__device__ __forceinline__ void topk_half(const bf16* qp, const bf16* kp0, int hh, unsigned (&L)[16]) {
    bf16x8 qf[8];
#pragma unroll
    for (int s = 0; s < 8; ++s) qf[s] = *(const bf16x8*)(qp + 16 * s);
    unsigned keys[64];
#pragma unroll
    for (int kt = 0; kt < 4; ++kt) {
        f32x16 S;
#pragma unroll
        for (int i = 0; i < 16; ++i) S[i] = 0.f;
        const bf16* kp = kp0 + (size_t)(32 * kt) * 128;
#pragma unroll
        for (int s = 0; s < 8; ++s) { const bf16x8 kf = *(const bf16x8*)(kp + 16 * s); S = MFMA32(kf, qf[s], S); }
#pragma unroll
        for (int i = 0; i < 16; ++i) { const int nidx = 32 * kt + (i & 3) + 8 * (i >> 2) + 4 * hh; keys[16 * kt + i] = (f2sort(S[i]) & ~0x7fu) | (unsigned)(127 - nidx); }
        asm volatile("" ::: "memory");
    }
    unsigned mine[16], oth[16];
    top16_of64(keys, mine);
#pragma unroll
    for (int k = 0; k < 16; ++k) oth[k] = (unsigned)__shfl_xor((int)mine[k], 32);
#pragma unroll
    for (int k = 0; k < 16; ++k) L[k] = umax(mine[k], oth[15 - k]);
#pragma unroll
    for (int st = 8; st >= 1; st >>= 1)
#pragma unroll
        for (int k = 0; k < 16; ++k) if ((k & st) == 0) { const unsigned hi = umax(L[k], L[k + st]), lo = umin(L[k], L[k + st]); L[k] = hi; L[k + st] = lo; }
}
#define PINU16(x) asm volatile("" : "+v"(x[0]), "+v"(x[1]), "+v"(x[2]), "+v"(x[3]), "+v"(x[4]), "+v"(x[5]), "+v"(x[6]), "+v"(x[7]), "+v"(x[8]), "+v"(x[9]), "+v"(x[10]), "+v"(x[11]), "+v"(x[12]), "+v"(x[13]), "+v"(x[14]), "+v"(x[15]) :: "memory")
__device__ __forceinline__ void p_peer_topk(LAS unsigned char* lds_, int layer) {
    Frame F; F.init(lds_); const kptr_t KP = kargs();
    const bf16* SKB = P_SKB + (size_t)layer * PH * 2 * NKEYS * 128;
    const int n = F.lane & 31, hh = F.lane >> 5;
    for (int item = F.gw; item < (T / 32) * PH; item += F.ngw) {
        int nn = n; asm volatile("" : "+v"(nn));
        const int h = item & 7, tb = item >> 3, t = 32 * tb + nn;
        unsigned LA[16], LB[16];
        topk_half(P_QR + (size_t)t * D + h * 256 + 8 * hh, SKB + ((size_t)(h * 2) * NKEYS + nn) * 128 + 8 * hh, hh, LA);
        PINU16(LA);
        topk_half(P_QR + (size_t)t * D + h * 256 + 128 + 8 * hh, SKB + ((size_t)(h * 2 + 1) * NKEYS + nn) * 128 + 8 * hh, hh, LB);
        PINU16(LB);
        float fA[16], fB[16];
#pragma unroll
        for (int k = 0; k < 16; ++k) { fA[k] = sort2f(LA[k] & ~0x7fu); fB[k] = sort2f(LB[k] & ~0x7fu);
        }
#define PK4(L, k) ((127u - (L[k] & 0x7fu)) | ((127u - (L[k + 1] & 0x7fu)) << 8) | ((127u - (L[k + 2] & 0x7fu)) << 16) | ((127u - (L[k + 3] & 0x7fu)) << 24))
        const unsigned pA0 = PK4(LA, 0), pA1 = PK4(LA, 4), pA2 = PK4(LA, 8), pA3 = PK4(LA, 12), pB0 = PK4(LB, 0), pB1 = PK4(LB, 4), pB2 = PK4(LB, 8), pB3 = PK4(LB, 12);
        unsigned cand[64]; int nc = 0;
#pragma unroll
        for (int k = 50; k < 64; ++k) cand[k] = 0u;
#pragma unroll
        for (int a = 0; a < 16; ++a)
#pragma unroll
            for (int bb = 0; bb < 16; ++bb) if ((a + 1) * (bb + 1) <= 16) { cand[nc] = (f2sort(fA[a] + fB[bb]) & ~0xffu) | (unsigned)(255 - (16 * a + bb)); ++nc; }
        unsigned sel[16];
        top16_of64(cand, sel);
        float val[16], ex[16], sum = 0.f; int eid[16];
#pragma unroll
        for (int k = 0; k < 16; ++k) { const int flat = 255 - (int)(sel[k] & 0xffu); val[k] = sort2f(sel[k] & ~0xffu);
            eid[k] = (int)(sel4(pA0, pA1, pA2, pA3, flat >> 4) * NKEYS + sel4(pB0, pB1, pB2, pB3, flat & 15)); }
#pragma unroll
        for (int k = 0; k < 16; ++k) { ex[k] = __expf(val[k] - val[0]); sum += ex[k]; }
        const float inv = 1.f / sum;
        if (hh == 0) {
            int* ip = P_IDS + (size_t)t * 128 + h * 16; float* gp = P_GATES + (size_t)t * 128 + h * 16;
#pragma unroll
            for (int k = 0; k < 16; k += 4) { *(v4u*)(ip + k) = (v4u){(unsigned)eid[k], (unsigned)eid[k + 1], (unsigned)eid[k + 2], (unsigned)eid[k + 3]};
                *(f32x4*)(gp + k) = (f32x4){ex[k] * inv, ex[k + 1] * inv, ex[k + 2] * inv, ex[k + 3] * inv}; }
        }
    }
}
#define SB() asm volatile("" ::: "memory")
__device__ __forceinline__ void sliced_groups(int b, int G, int& grp, int& rank, int& nrank, int& ng) { ng = G < 8 ? G : 8; grp = b % ng; rank = b / ng; nrank = (G - grp + ng - 1) / ng; }
#define PS_TOK(i_) (t0 + (((i_) < n) ? (i_) : (n - 1)) * tstep)
#define PS_IDS(ida, idb, i_) do { const int t_ = PS_TOK(i_); ida = P_IDS[(size_t)t_ * 128 + F.lane]; idb = P_IDS[(size_t)t_ * 128 + 64 + F.lane]; } while (0)
#define PS_ROWS(W, ida, idb, base) do { _Pragma("unroll") for (int j_ = 0; j_ < 16; ++j_) { const int id_ = __shfl((j_ & 8) ? idb : ida, 8 * (j_ & 7) + (F.lane >> 3)); W[j_] = *(const v4u*)((base) + (size_t)id_ * 128); } } while (0)
#define PG_CVT4(w_, b_) __builtin_amdgcn_cvt_scalef32_pk_f32_fp4((unsigned)(w_), 1.0f, (b_))
typedef int v8i_t __attribute__((ext_vector_type(8)));
typedef float f32x4m __attribute__((ext_vector_type(4)));
#define PS_XLD(X, i_) do { const unsigned char* xp_ = P_H8 + (size_t)PS_TOK(i_) * (D / 2) + s * 128 + 16 * xb; \
        X[0] = (v4u){0u, 0u, 0u, 0u}; X[1] = X[0]; \
        if (xuse) { X[0] = *(const v4u*)xp_; X[1] = *(const v4u*)(xp_ + 64); } } while (0)
#define PS_UCOMP(W, X, i_) do { \
        const v8i_t b0_ = (v8i_t){(int)X[0].x, (int)X[0].y, (int)X[0].z, (int)X[0].w, 0, 0, 0, 0}; \
        const v8i_t b1_ = (v8i_t){(int)X[1].x, (int)X[1].y, (int)X[1].z, (int)X[1].w, 0, 0, 0, 0}; \
        float v_[16]; \
        _Pragma("unroll") for (int j_ = 0; j_ < 16; ++j_) { const v8i_t a_ = (v8i_t){(int)W[j_].x, (int)W[j_].y, (int)W[j_].z, (int)W[j_].w, 0, 0, 0, 0}; \
            const f32x4m z4_ = (f32x4m){0.f, 0.f, 0.f, 0.f}; \
            const f32x4m c0_ = __builtin_amdgcn_mfma_scale_f32_16x16x128_f8f6f4(a_, b0_, z4_, 4, 4, 0, 0x7f7f7f7f, 0, 0x7f7f7f7f); \
            const f32x4m c1_ = __builtin_amdgcn_mfma_scale_f32_16x16x128_f8f6f4(a_, b1_, z4_, 4, 4, 0, 0x7f7f7f7f, 0, 0x7f7f7f7f); \
            const float e0_ = csel1 ? c1_[0] : c0_[0], e1_ = csel1 ? c1_[1] : c0_[1], e2_ = csel1 ? c1_[2] : c0_[2], e3_ = csel1 ? c1_[3] : c0_[3]; \
            v_[j_] = (creg & 2) ? ((creg & 1) ? e3_ : e2_) : ((creg & 1) ? e1_ : e0_); } \
        float w8_[8], y4_[4], z0_, z1_; \
        _Pragma("unroll") for (int m_ = 0; m_ < 8; ++m_) { const bool up_ = F.lane & 4; const float keep_ = up_ ? v_[2 * m_ + 1] : v_[2 * m_], send_ = up_ ? v_[2 * m_] : v_[2 * m_ + 1]; w8_[m_] = keep_ + __shfl_xor(send_, 4); } \
        _Pragma("unroll") for (int m_ = 0; m_ < 4; ++m_) { const bool up_ = F.lane & 8; const float keep_ = up_ ? w8_[2 * m_ + 1] : w8_[2 * m_], send_ = up_ ? w8_[2 * m_] : w8_[2 * m_ + 1]; y4_[m_] = keep_ + __shfl_xor(send_, 8); } \
        { const bool up_ = F.lane & 16; z0_ = (up_ ? y4_[1] : y4_[0]) + __shfl_xor(up_ ? y4_[0] : y4_[1], 16); z1_ = (up_ ? y4_[3] : y4_[2]) + __shfl_xor(up_ ? y4_[2] : y4_[3], 16); } \
        asm volatile("" : "+v"(z0_), "+v"(z1_) :: "memory"); \
        if ((i_) < n) ((unsigned*)P_PART)[((size_t)PS_TOK(i_) * 8 + s) * 64 + F.lane] = pk2(z0_, z1_); } while (0)
__device__ __forceinline__ void p_peer_u(LAS unsigned char* lds_, int layer) {
    Frame F; F.init(lds_); const kptr_t KP = kargs();
    int grp, rank, nrank, ng; sliced_groups(F.gw / NWAVES, F.G, grp, rank, nrank, ng);
    const int r = F.lane & 7;
    const bool xuse = (F.lane & 3) == (F.lane >> 4), csel1 = (F.lane >> 4) & 1; const int xb = (F.lane >> 2) & 3, creg = (F.lane >> 2) & 3;
    const int t0 = rank * NWAVES + F.wave, tstep = nrank * NWAVES, n = (T - t0 + tstep - 1) / tstep;
#pragma unroll 1
    for (int s = grp; s < 8; s += ng) {
        const unsigned char* Us = P_U8 + ((size_t)(layer * 8 + s) * NEXP) * 128 + 16 * r;
        int iEa, iEb, iOa, iOb; v4u xE[2], xO[2]; v4u WA[16], WB[16];
        PS_IDS(iEa, iEb, 0); PS_XLD(xE, 0); PS_IDS(iOa, iOb, 1); PS_XLD(xO, 1);
        PS_ROWS(WA, iEa, iEb, Us); SB();
#pragma unroll 1
        for (int i = 0; i < n; i += 2) {
            PS_ROWS(WB, iOa, iOb, Us); PS_IDS(iEa, iEb, i + 2); SB();
            PS_UCOMP(WA, xE, i); PS_XLD(xE, i + 2); SB();
            PS_ROWS(WA, iEa, iEb, Us); PS_IDS(iOa, iOb, i + 3); SB();
            PS_UCOMP(WB, xO, i + 1); PS_XLD(xO, i + 3); SB();
        }
    }
}
__device__ __forceinline__ void p_peer_a(LAS unsigned char* lds_) {
    Frame F; F.init(lds_); const kptr_t KP = kargs();
    const int pl = 8 * ((F.lane >> 2) & 7) + (F.lane >> 5) + 2 * (F.lane & 3);
    for (int tb = F.gw; tb < T; tb += 2 * F.ngw) {
        unsigned pw[2][8]; float gg[2][2], rs[2];
#pragma unroll
        for (int q = 0; q < 2; ++q) { const int t = (tb + q * F.ngw < T) ? tb + q * F.ngw : tb;
            const unsigned* pp = (const unsigned*)P_PART + (size_t)t * 8 * 64 + F.lane;
#pragma unroll
            for (int s = 0; s < 8; ++s) pw[q][s] = pp[s * 64];
            gg[q][0] = P_GATES[(size_t)t * 128 + pl]; gg[q][1] = P_GATES[(size_t)t * 128 + 64 + pl];
            rs[q] = row_rstd(P_SSQ1, t) * (1.f / (USCALE * XS4)); }
#pragma unroll
        for (int q = 0; q < 2; ++q) {
            const int t = tb + q * F.ngw;
            float s0 = 0.f, s1 = 0.f;
#pragma unroll
            for (int s = 0; s < 8; ++s) { s0 += bflo(pw[q][s]); s1 += bfhi(pw[q][s]); }
            const float d0 = s0 * rs[q], d1 = s1 * rs[q];
            if (t < T) {
                P_AG[(size_t)t * 128 + F.lane] = 0.5f * d0 * (1.f + erff(d0 * 0.70710678118654752f)) * (gg[q][0] * (1.f / VSCALE));
                P_AG[(size_t)t * 128 + 64 + F.lane] = 0.5f * d1 * (1.f + erff(d1 * 0.70710678118654752f)) * (gg[q][1] * (1.f / VSCALE)); }
        }
    }
}
#define PS_ALD(aa, ab, hv, i_) do { const int t_ = PS_TOK(i_); aa = P_AG[(size_t)t_ * 128 + F.lane]; ab = P_AG[(size_t)t_ * 128 + 64 + F.lane]; hv = *(const v2u*)(P_HBA + (size_t)t_ * D + coff); } while (0)
typedef _Float16 h2_t __attribute__((ext_vector_type(2)));
#define PG_CVT4H(w_, b_) __builtin_bit_cast(h2_t, __builtin_amdgcn_cvt_scalef32_pk_f16_fp4((unsigned)(w_), 1.0f, (b_)))
#define H2_SHX(v_, k_) __builtin_bit_cast(h2_t, __shfl_xor(__builtin_bit_cast(int, (v_)), (k_)))
#define PS_VFMA4(k0_, w_) do { acc_[(k0_)] = __builtin_elementwise_fma(PG_CVT4H(w_, 0), a_, acc_[(k0_)]); acc_[(k0_) + 1] = __builtin_elementwise_fma(PG_CVT4H(w_, 1), a_, acc_[(k0_) + 1]); \
        acc_[(k0_) + 2] = __builtin_elementwise_fma(PG_CVT4H(w_, 2), a_, acc_[(k0_) + 2]); acc_[(k0_) + 3] = __builtin_elementwise_fma(PG_CVT4H(w_, 3), a_, acc_[(k0_) + 3]); } while (0)
#define PS_VCOMP(W, aa, ab, hv, i_) do { \
        h2_t acc_[16]; \
        _Pragma("unroll") for (int k_ = 0; k_ < 16; ++k_) acc_[k_] = (h2_t){(_Float16)0.f, (_Float16)0.f}; \
        _Pragma("unroll") for (int j_ = 0; j_ < 16; ++j_) { const float aj_ = __shfl((j_ & 8) ? ab : aa, gq + 4 * (j_ & 7)); const _Float16 ah_ = (_Float16)aj_; const h2_t a_ = (h2_t){ah_, ah_}; \
            PS_VFMA4(0, W[j_].x); PS_VFMA4(4, W[j_].y); PS_VFMA4(8, W[j_].z); PS_VFMA4(12, W[j_].w); } \
        h2_t w8_[8], y4_[4], zz_[2]; float z_[4]; \
        _Pragma("unroll") for (int k_ = 0; k_ < 8; ++k_) { const bool up_ = F.lane & 8; const h2_t keep_ = up_ ? acc_[k_ + 8] : acc_[k_], send_ = up_ ? acc_[k_] : acc_[k_ + 8]; w8_[k_] = keep_ + H2_SHX(send_, 8); } \
        _Pragma("unroll") for (int k_ = 0; k_ < 4; ++k_) { const bool up_ = F.lane & 16; const h2_t keep_ = up_ ? w8_[k_ + 4] : w8_[k_], send_ = up_ ? w8_[k_] : w8_[k_ + 4]; y4_[k_] = keep_ + H2_SHX(send_, 16); } \
        _Pragma("unroll") for (int k_ = 0; k_ < 2; ++k_) { const bool up_ = F.lane & 32; const h2_t keep_ = up_ ? y4_[k_ + 2] : y4_[k_], send_ = up_ ? y4_[k_] : y4_[k_ + 2]; zz_[k_] = keep_ + H2_SHX(send_, 32); } \
        z_[0] = (float)zz_[0].x; z_[1] = (float)zz_[0].y; z_[2] = (float)zz_[1].x; z_[3] = (float)zz_[1].y; \
        v2u hn_; hn_.x = pk2(bflo(hv.x) + z_[0], bfhi(hv.x) + z_[1]); hn_.y = pk2(bflo(hv.y) + z_[2], bfhi(hv.y) + z_[3]); \
        float ss_ = wave_sum((bflo(hn_.x) * bflo(hn_.x) + bfhi(hn_.x) * bfhi(hn_.x)) + (bflo(hn_.y) * bflo(hn_.y) + bfhi(hn_.y) * bfhi(hn_.y))); \
        asm volatile("" : "+v"(hn_.x), "+v"(hn_.y), "+v"(ss_) :: "memory"); \
        v2s_t g8_ = (v2s_t){0, 0}; g8_ = __builtin_amdgcn_cvt_scalef32_pk_fp8_f32(g8_, bflo(hn_.x), bfhi(hn_.x), 1.0f, false); g8_ = __builtin_amdgcn_cvt_scalef32_pk_fp8_f32(g8_, bflo(hn_.y), bfhi(hn_.y), 1.0f, true); \
        if ((i_) < n) { const size_t off_ = (size_t)PS_TOK(i_) * D + coff; *(v2u*)(P_HBA + off_) = hn_; *(unsigned*)(P_HG8 + off_) = __builtin_bit_cast(unsigned, g8_);        \
            if (F.lane == 0) { float* sq_ = P_SSQ2 + (size_t)PS_TOK(i_) * 32 + s; sq_[0] = ss_; sq_[8] = 0.f; sq_[16] = 0.f; sq_[24] = 0.f; } } } while (0)
__device__ __forceinline__ void p_peer_v(LAS unsigned char* lds_, int layer) {
    Frame F; F.init(lds_); const kptr_t KP = kargs();
    int grp, rank, nrank, ng; sliced_groups(F.gw / NWAVES, F.G, grp, rank, nrank, ng);
    const int r = F.lane & 7, gq = (((F.lane >> 3) & 1) << 5) | (F.lane >> 4);
    const int gsel = 16 * ((F.lane >> 3) & 1) + 8 * ((F.lane >> 4) & 1) + 4 * ((F.lane >> 5) & 1);
    const int t0 = rank * NWAVES + F.wave, tstep = nrank * NWAVES, n = (T - t0 + tstep - 1) / tstep;
#pragma unroll 1
    for (int s = grp; s < 8; s += ng) {
        const unsigned char* Vs = P_V8 + ((size_t)(layer * 8 + s) * NEXP) * 128 + 16 * r;
        const int coff = s * 256 + 32 * r + gsel;
        int iEa, iEb, iOa, iOb; float aEa, aEb, aOa, aOb; v2u hE, hO; v4u WA[16], WB[16];
        PS_IDS(iEa, iEb, 0); PS_ALD(aEa, aEb, hE, 0); PS_IDS(iOa, iOb, 1); PS_ALD(aOa, aOb, hO, 1);
        PS_ROWS(WA, iEa, iEb, Vs); SB();
#pragma unroll 1
        for (int i = 0; i < n; i += 2) {
            PS_ROWS(WB, iOa, iOb, Vs); PS_IDS(iEa, iEb, i + 2); SB();
            PS_VCOMP(WA, aEa, aEb, hE, i); PS_ALD(aEa, aEb, hE, i + 2); SB();
            PS_ROWS(WA, iEa, iEb, Vs); PS_IDS(iOa, iOb, i + 3); SB();
            PS_VCOMP(WB, aOa, aOb, hO, i + 1); PS_ALD(aOa, aOb, hO, i + 3); SB();
        }
    }
}
__device__ __forceinline__ void p_final(LAS unsigned char* lds_) {
    Frame F; F.init(lds_); const kptr_t KP = kargs();
    for (int t = F.gw; t < T; t += F.ngw) {
        const float rstd = row_rstd(P_SSQ0, t);
#pragma unroll
        for (int j = 0; j < 8; ++j) {
            const size_t c = j * 256 + F.lane * 4;
            const v2u hw = *(const v2u*)(P_HBB + (size_t)t * D + c); const f32x4 h4 = (f32x4){bflo(hw.x), bfhi(hw.x), bflo(hw.y), bfhi(hw.y)}, g = *(const f32x4*)(P_final_norm + c);
            *(f32x4*)(kout(KP) + (size_t)t * D + c) = h4 * rstd * g;
        }
    }
}

__device__ __forceinline__ int lg() { int g_ = gridDim.x; asm volatile("" : "+s"(g_)); return g_; }
__device__ __forceinline__ int lb() { int b_ = blockIdx.x; asm volatile("" : "+s"(b_)); return b_; }
__device__ __forceinline__ void grid_seam(LAS unsigned char* lds) {
    XcdBarrier b; b.bar = (unsigned*)(kws(kargs()) + WS_CTL) + CW_BAR; b.x = xb_xcc_id(); b.st = (volatile LAS unsigned*)(lds + MISC_OFF);
    xcd_barrier(b);
}
template <int L> struct LTag { static constexpr int value = L; };
__global__ void __launch_bounds__(NTHREADS, 2) fwd_kernel(Args args) {
    extern __shared__ __attribute__((aligned(16))) unsigned char lds_raw[];
    LAS unsigned char* lds = (LAS unsigned char*)lds_raw;
    for (int u = threadIdx.x; u < (LDS_BYTES - LDSCTL_OFF) / 4; u += NTHREADS) ((LAS unsigned*)(lds + LDSCTL_OFF))[u] = 0u;
    __syncthreads();
#define PH_LO (*(const int CAS*)(kargs() + 152))
#define PH_HI (*(const int CAS*)(kargs() + 156))
    if (PH_HI - PH_LO > 1) (void)xcd_barrier_post((unsigned*)(kws(kargs()) + WS_CTL) + CW_BAR, (volatile LAS unsigned*)(lds + MISC_OFF));
#ifndef PH_MASK
#define PH_MASK 0x3ff
#endif
#define EN(i) ((PH_MASK >> (i)) & 1)
#define RUN(k) ((k) >= PH_LO && (k) < PH_HI)
#ifdef PROBE_BAR2
#define SEAM(k) do { if ((k) + 1 < PH_HI) { grid_seam(lds); grid_seam(lds); } } while (0)
#else
#define SEAM(k) do { if ((k) + 1 < PH_HI) grid_seam(lds); } while (0)
#endif

    #ifdef PROBE_PRO2
    if (EN(0) && RUN(0)) { p_prologue(lds); __syncthreads(); }
#endif
    if (EN(0) && RUN(0)) { p_prologue(lds); SEAM(0); }
    auto layer_body = [&](auto layer_tag) __attribute__((always_inline)) {
        constexpr int layer = decltype(layer_tag)::value;
        const int ph0 = 1 + layer * PHASES_PER_LAYER;
        if (EN(1) && RUN(ph0 + 0)) {
            { const kptr_t KP = kargs();
              pg8::Gemm g{P_HBB, P_Wt_in + (size_t)layer * INW * D, T, QW, D}; pg8::StaticOrder S; S.init(T, QW, lg(), lb());
#ifdef PROBE_GEMM2
              { EpiNull E0{0}; pg8::gemm_phase<EpiNull, pg8::StaticOrder, true, true>(lds, g, S, E0); }
#endif
              EpiInProj E{0};
              pg8::gemm_phase<EpiInProj, pg8::StaticOrder, true, true>(lds, g, S, E); }
            { const kptr_t KP = kargs();
              pg8::Gemm g{P_HBB, P_Wt_in + (size_t)layer * INW * D + (size_t)QW * D, T, 1024, D}; pg8::StaticOrder S; S.init(T, 1024, lg(), lb());
              EpiVa E{0};
              pg8::gemm_phase<EpiVa, pg8::StaticOrder, true, true>(lds, g, S, E); }
            { const kptr_t KP = kargs();
              pg8::Gemm g{P_Wt_in + (size_t)layer * INW * D + (size_t)5120 * D, P_HBB, 1024, T, D}; pg8::StaticOrder S; S.init(1024, T, lg(), lb());
#ifdef PROBE_GEMM2
              { EpiNull E0{0}; pg8::gemm_phase<EpiNull, pg8::StaticOrder, true, true>(lds, g, S, E0); }
#endif
              EpiVbT E{0};
              pg8::gemm_phase<EpiVbT, pg8::StaticOrder, true, true>(lds, g, S, E); }
            SEAM(ph0 + 0); }
        if (EN(2) && RUN(ph0 + 1)) {
#ifdef PROBE_ATT2
            p_attn_dilated(lds); p_attn_stick(lds);
#endif
#ifdef PROBE_DIL2
            p_attn_dilated(lds);
#endif
#ifdef PROBE_STK2
            p_attn_stick(lds);
#endif
#ifndef NO_DIL
            p_attn_dilated(lds);
#endif
#ifndef NO_STICK
            p_attn_stick(lds);
#endif
            SEAM(ph0 + 1); }
        if (EN(3) && RUN(ph0 + 2)) {
#ifdef PROBE_COMB2
            p_combine(lds);
#endif
            p_combine(lds); SEAM(ph0 + 2); }
        if (EN(4) && RUN(ph0 + 3)) {
            const kptr_t KP = kargs();
            pg8::Gemm g{P_MIX, P_Wt_out + (size_t)layer * D * D, T, D, D}; pg8::StaticOrder S; S.init(T, D, lg(), lb());
#ifdef PROBE_GEMM2
            { EpiNull E0{0}; pg8::gemm_phase<EpiNull, pg8::StaticOrder, true, true>(lds, g, S, E0); }
#endif
            EpiResid<0> E{0};
            pg8::gemm_phase<EpiResid<0>, pg8::StaticOrder, true, true>(lds, g, S, E);
            SEAM(ph0 + 3); }
        if (EN(5) && RUN(ph0 + 4)) {
            { const kptr_t KP = kargs();
              pg8::Gemm g{P_HBA, P_Wt_q + (size_t)layer * D * D, T, D, D}; pg8::StaticOrder S; S.init(T, D, lg(), lb());
#ifdef PROBE_GEMM2
              { EpiNull E0{0}; pg8::gemm_phase<EpiNull, pg8::StaticOrder, true, true>(lds, g, S, E0); }
#endif
              EpiBf16Scale E{0};
              pg8::gemm_phase<EpiBf16Scale, pg8::StaticOrder, true, true>(lds, g, S, E); }
            { const kptr_t KP = kargs();
              pg8::Gemm g{P_PB + (size_t)layer * T * PLE, P_Wt_p + (size_t)layer * D * PLE, T, D, PLE}; pg8::StaticOrder S; S.init(T, D, lg(), lb());
#ifdef PROBE_GEMM2
              { EpiNull E0{0}; pg8::gemm_phase<EpiNull, pg8::StaticOrder, true, true>(lds, g, S, E0); }
#endif
              EpiBf16Scale E{1};
              pg8::gemm_phase<EpiBf16Scale, pg8::StaticOrder, true, true>(lds, g, S, E); }
            SEAM(ph0 + 4); }
        if (EN(6) && RUN(ph0 + 5)) {
#ifdef PROBE_TOPK2
            p_peer_topk(lds, layer);
#endif
            p_peer_topk(lds, layer); SEAM(ph0 + 5); }
        if (EN(7) && RUN(ph0 + 6)) {
#ifdef PROBE_U2
            p_peer_u(lds, layer);
#endif
            p_peer_u(lds, layer); SEAM(ph0 + 6); }
        if (EN(7) && RUN(ph0 + 7)) {
#ifdef PROBE_A2
            p_peer_a(lds);
#endif
            p_peer_a(lds); SEAM(ph0 + 7); }
        if (EN(7) && RUN(ph0 + 8)) { p_peer_v(lds, layer); SEAM(ph0 + 8); }
        if (EN(8) && RUN(ph0 + 9)) {
            const kptr_t KP = kargs();
#ifdef GATE_BF16
            pg8::Gemm g{P_HBA, P_Wt_g + (size_t)layer * D * D, T, D, D}; pg8::StaticOrder S; S.init(T, D, lg(), lb());
#else
            pg8::Gemm g{(const bf16*)P_HG8, (const bf16*)(P_WG8 + (size_t)layer * D * D), T, D, D}; pg8::StaticOrder S; S.init(T, D, lg(), lb());
#endif
#ifdef PROBE_GEMM2
            { EpiNull E0{0}; pg8::gemm_phase<EpiNull, pg8::StaticOrder, true, true>(lds, g, S, E0); }
#endif
            EpiResid<1> E{0};
#ifdef GATE_BF16
            pg8::gemm_phase<EpiResid<1>, pg8::StaticOrder, true, true>(lds, g, S, E);
#else
            pg8::gemm_phase<EpiResid<1>, pg8::StaticOrder, true, true, 1, 121>(lds, g, S, E);
#endif
            SEAM(ph0 + 9); }
    };
    layer_body(LTag<0>{}); layer_body(LTag<1>{}); layer_body(LTag<2>{}); layer_body(LTag<3>{});
    static_assert(DEPTH == 4, "four copies");
    if (EN(9) && RUN(NPH - 1)) { p_final(lds); }
#undef RUN
#undef SEAM
}

extern "C" void kernel_launch(void* const* d_in, const int* in_sizes, int n_in, void* d_out, int out_size, void* d_ws, size_t ws_size, hipStream_t stream) {
    static int grid = 0;
    if (grid == 0) {
        if (n_in != 17 || out_size != T * D || ws_size < WS_END) { fprintf(stderr, "kernel_launch: unexpected shapes (n_in %d out %d ws %zu need %zu)\n", n_in, out_size, ws_size, (size_t)WS_END); grid = -1; return; }
        int dev = 0, cus = 0, per_cu = 0;
        if (hipGetDevice(&dev) != hipSuccess || hipDeviceGetAttribute(&cus, hipDeviceAttributeMultiprocessorCount, dev) != hipSuccess) { grid = -1; return; }
        if (hipFuncSetAttribute((const void*)fwd_kernel, hipFuncAttributeMaxDynamicSharedMemorySize, LDS_BYTES) != hipSuccess) { fprintf(stderr, "kernel_launch: hipFuncSetAttribute failed\n"); grid = -1; return; }
        if (hipOccupancyMaxActiveBlocksPerMultiprocessor(&per_cu, (const void*)fwd_kernel, NTHREADS, LDS_BYTES) != hipSuccess || per_cu < 1) { fprintf(stderr, "kernel_launch: occupancy query says %d\n", per_cu); }
        (void)hipGetLastError();
        grid = cus;
    }
    if (grid < 0) return;
    (void)hipMemsetAsync((char*)d_ws + WS_CTL, 0, CTL_ZERO_BYTES, stream);
    Args a{};
    for (int i = 0; i < 17; ++i) a.in[i] = d_in[i];
    a.out = (float*)d_out; a.ws = (unsigned char*)d_ws;
    if (MK_N_LAUNCHES == 1) {
        a.ph_lo = 0; a.ph_hi = NPH;
        hipLaunchKernelGGL(fwd_kernel, dim3(grid), dim3(NTHREADS), LDS_BYTES, stream, a);
    } else {
        for (int k = 0; k < NPH; ++k) { a.ph_lo = k; a.ph_hi = k + 1; hipLaunchKernelGGL(fwd_kernel, dim3(grid), dim3(NTHREADS), LDS_BYTES, stream, a); }
    }
    const hipError_t le = hipPeekAtLastError();
    if (le != hipSuccess) fprintf(stderr, "kernel_launch: launch failed: %s\n", hipGetErrorName(le));
}
```

```cpp
#include <hip/hip_runtime.h>
#include <cstdio>
#include <cstdint>
namespace pg8 {
#define PG8_LAS __attribute__((address_space(3)))
typedef unsigned short bf16_t;
typedef short bf16x8 __attribute__((ext_vector_type(8)));
typedef float f32x4 __attribute__((ext_vector_type(4)));
typedef unsigned u32x4 __attribute__((ext_vector_type(4)));
typedef int i32x8 __attribute__((ext_vector_type(8)));
constexpr int BM = 256, BK = 64, HALF = 128, HTB = HALF * BK * 2  , STAGE_BYTES = 8 * HTB, NXCD = 8, WGM = 8;

__host__ __device__ __forceinline__ int lds_byte(int r, int c) { const int st = (r >> 4) * 2 + (c >> 5), rr = r & 15, cc = c & 31, ob = rr * 64 + cc * 2; return st * 1024 + (ob ^ (((ob >> 9) & 1) << 5)); }
__host__ __device__ __forceinline__ void stage_rc(int b, int& R, int& C) { const int st = b / 1024, sb = b % 1024, swz = sb ^ (((sb >> 9) & 1) << 5); R = (st >> 1) * 16 + swz / 64; C = (st & 1) * 32 + (swz % 64) / 2; }
__host__ __device__ __forceinline__ int perm32(int rho) { const int n = rho >> 4, i = rho & 15; return 8 * (i >> 2) + 4 * n + (i & 3); }

struct Unit { int pm, pn; };
struct Gemm { const bf16_t* A; const bf16_t* Bt; int M, N, K; };

struct StaticOrder {
    int nM, nN, nwg, G, c;
    __host__ __device__ void init(int M, int N, int G_, int c_) { nM = M / BM; nN = N / BM; nwg = nM * nN; G = G_; c = c_; }
    __host__ __device__ bool next(int i, Unit& u) const {
        const long L = (long)i * G + c; if (L >= nwg) return false;
        int wgid = (int)L; { const int q = nwg / NXCD, r = nwg % NXCD, xcd = wgid % NXCD, off = wgid / NXCD; wgid = (xcd < r ? xcd * (q + 1) : r * (q + 1) + (xcd - r) * q) + off; }
        const int nig = WGM * nN, gid = wgid / nig, fm = gid * WGM, gsz = (nM - fm) < WGM ? (nM - fm) : WGM;
        u.pm = fm + ((wgid % nig) % gsz); u.pn = (wgid % nig) / gsz; return true;
    }
    __device__ __forceinline__ void a_ready(const Unit&) const {}
    __device__ __forceinline__ void done(const Unit&) const {}
};

__device__ __forceinline__ unsigned cvt_pk_bf16(float lo, float hi) { unsigned r; asm volatile("v_cvt_pk_bf16_f32 %0, %1, %2" : "=v"(r) : "v"(lo), "v"(hi)); return r; }
template <class Epi, class Sched, bool ALIGN_EPI = false, bool SP2 = false, int ES = 2, int SCALE_W = 127>
__device__ __forceinline__ void gemm_phase(PG8_LAS unsigned char* lds, const Gemm g, const Sched& S, const Epi& E) {
    int tid_ = threadIdx.x; asm volatile("" : "+v"(tid_));
    const int tid = tid_, wid = __builtin_amdgcn_readfirstlane(tid >> 6), lane = tid & 63, wr = wid >> 2, wc = wid & 3, fr = lane & 15, fq = lane >> 4;
    const int K = g.K, nt = K * ES / (BK * 2);
    unsigned voffA[2], voffB[2];
#pragma unroll
    for (int i = 0; i < 2; ++i) { int R, C; stage_rc(tid * 16 + i * 8192, R, C); const int Rb = Epi::PERM ? ((R & ~31) + perm32(R & 31)) : R;
        voffA[i] = (unsigned)(R * K * ES + C * 2); voffB[i] = (unsigned)(Rb * K * ES + C * 2); }
    const size_t kstep = (size_t)(BK * 2);
    const size_t hstep = (size_t)HALF * K * ES;
    const size_t tstep = 2 * hstep;
    const unsigned ldsw = (unsigned)wid * 1024u;
    const int aoff = lds_byte(wr * 64 + fr, fq * 8), boff = lds_byte(wc * 32 + fr, fq * 8);
#define PG8_SA(b, h) (((b) * 2 + (h)) * HTB)
#define PG8_SB(b, h) ((4 + (b) * 2 + (h)) * HTB)
#define PG8_STAGE(bufoff, gbase, voff) do { _Pragma("unroll") for (int _i = 0; _i < 2; ++_i) \
        __builtin_amdgcn_global_load_lds((const unsigned*)((const char*)(gbase) + (voff)[_i]), (PG8_LAS unsigned*)(lds + (bufoff) + ldsw + _i * 8192), 16, 0, 0); } while (0)
#define PG8_CAT8(lo_, hi_) (i32x8){(int)(lo_).x, (int)(lo_).y, (int)(lo_).z, (int)(lo_).w, (int)(hi_).x, (int)(hi_).y, (int)(hi_).z, (int)(hi_).w}
#define PG8_LDA(dst, b, h) do { if constexpr (ES == 2) { _Pragma("unroll") for (int m = 0; m < 4; ++m) _Pragma("unroll") for (int k = 0; k < 2; ++k) dst[m][k] = *(const PG8_LAS bf16x8*)(lds + PG8_SA(b, h) + aoff + m * 2048 + k * 1024); } \
        else { _Pragma("unroll") for (int m = 0; m < 4; ++m) { const u32x4 lo_ = *(const PG8_LAS u32x4*)(lds + PG8_SA(b, h) + aoff + m * 2048), hi_ = *(const PG8_LAS u32x4*)(lds + PG8_SA(b, h) + aoff + m * 2048 + 1024); dst##8[m] = PG8_CAT8(lo_, hi_); } } } while (0)
#define PG8_LDB(dst, b, h) do { if constexpr (ES == 2) { _Pragma("unroll") for (int n = 0; n < 2; ++n) _Pragma("unroll") for (int k = 0; k < 2; ++k) dst[n][k] = *(const PG8_LAS bf16x8*)(lds + PG8_SB(b, h) + boff + n * 2048 + k * 1024); } \
        else { _Pragma("unroll") for (int n = 0; n < 2; ++n) { const u32x4 lo_ = *(const PG8_LAS u32x4*)(lds + PG8_SB(b, h) + boff + n * 2048), hi_ = *(const PG8_LAS u32x4*)(lds + PG8_SB(b, h) + boff + n * 2048 + 1024); dst##8[n] = PG8_CAT8(lo_, hi_); } } } while (0)
#define PG8_MMA(ai, bj, At, Bt) do { __builtin_amdgcn_s_setprio(1); _Pragma("unroll") for (int m = 0; m < 4; ++m) _Pragma("unroll") for (int n = 0; n < 2; ++n) { \
        if constexpr (ES == 2) { _Pragma("unroll") for (int k = 0; k < 2; ++k) acc[ai][bj][m][n] = __builtin_amdgcn_mfma_f32_16x16x32_bf16(Bt[n][k], At[m][k], acc[ai][bj][m][n], 0, 0, 0); } \
        else asm volatile("v_mfma_scale_f32_16x16x128_f8f6f4 %0, %1, %2, %0, %3, %4 op_sel_hi:[0,0,0]" : "+v"(acc[ai][bj][m][n]) : "v"(Bt##8[n]), "v"(At##8[m]), "v"(sclw_), "v"(scla_));        } \
        __builtin_amdgcn_s_setprio(0); } while (0)
#define PG8_WAIT_V(n) asm volatile("s_waitcnt vmcnt(" #n ")" ::: "memory")
#define PG8_WAIT_L(n) asm volatile("s_waitcnt lgkmcnt(" #n ")" ::: "memory")
#define PG8_BAR __builtin_amdgcn_s_barrier()
#define PG8_SCHED __builtin_amdgcn_sched_barrier(0)
    Unit cur, nxt; int ui = 0;
    if (!S.next(0, cur)) return;
    f32x4 acc[2][2][4][2];
#pragma unroll
    for (int a = 0; a < 2; ++a)
#pragma unroll
        for (int b = 0; b < 2; ++b)
#pragma unroll
            for (int m = 0; m < 4; ++m)
#pragma unroll
                for (int n = 0; n < 2; ++n) acc[a][b][m][n] = (f32x4){0.f, 0.f, 0.f, 0.f};
    const int sclw_ = SCALE_W * 0x01010101, scla_ = 0x7f7f7f7f;
    bf16x8 At[4][2], B0[2][2], B1[2][2]; i32x8 At8[4], B08[2], B18[2];
    const char* cA = (const char*)g.A + (size_t)cur.pm * tstep; const char* cB = (const char*)g.Bt + (size_t)cur.pn * tstep;
    S.a_ready(cur);
    if constexpr (SP2) {
        PG8_STAGE(PG8_SB(0, 0), cB, voffB); PG8_STAGE(PG8_SB(0, 1), cB + hstep, voffB); PG8_STAGE(PG8_SA(0, 0), cA, voffA); PG8_STAGE(PG8_SA(0, 1), cA + hstep, voffA);
        if (wr == 1) PG8_BAR;
        PG8_WAIT_V(2); PG8_BAR;
        PG8_STAGE(PG8_SB(1, 0), cB + kstep, voffB); PG8_STAGE(PG8_SA(1, 0), cA + kstep, voffA); PG8_STAGE(PG8_SB(1, 1), cB + hstep + kstep, voffB);
        PG8_WAIT_V(6); PG8_BAR;
    } else {
        PG8_STAGE(PG8_SB(0, 0), cB, voffB); PG8_STAGE(PG8_SA(0, 0), cA, voffA); PG8_STAGE(PG8_SB(0, 1), cB + hstep, voffB); PG8_STAGE(PG8_SA(0, 1), cA + hstep, voffA);
        if (wr == 1) PG8_BAR;
        PG8_WAIT_V(4); PG8_BAR;
        PG8_STAGE(PG8_SB(1, 0), cB + kstep, voffB); PG8_STAGE(PG8_SA(1, 0), cA + kstep, voffA); PG8_STAGE(PG8_SB(1, 1), cB + hstep + kstep, voffB);
        PG8_WAIT_V(6); PG8_BAR;
    }
    for (;;) {
        const bool has_next = S.next(ui + 1, nxt);
        const char* nA = has_next ? (const char*)g.A + (size_t)nxt.pm * tstep : cA; const char* nB = has_next ? (const char*)g.Bt + (size_t)nxt.pn * tstep : cB;
        for (int t = 0; t < nt; t += 2) {
            const bool last = (t == nt - 2);
            const char* a1 = cA + (size_t)(t + 1) * kstep;
            const char* a2 = last ? nA : cA + (size_t)(t + 2) * kstep; const char* b2 = last ? nB : cB + (size_t)(t + 2) * kstep;
            const char* a3 = a2 + kstep; const char* b3 = b2 + kstep;
            if (last && has_next) S.a_ready(nxt);
            if constexpr (SP2) {
            PG8_LDB(B0, 0, 0); PG8_LDB(B1, 0, 1); PG8_SCHED; PG8_LDA(At, 0, 0); PG8_STAGE(PG8_SA(1, 1), a1 + hstep, voffA);
            PG8_WAIT_V(8); PG8_WAIT_L(0); PG8_BAR; PG8_MMA(0, 0, At, B0); PG8_MMA(0, 1, At, B1); PG8_BAR; PG8_SCHED;
            PG8_LDA(At, 0, 1); PG8_STAGE(PG8_SB(0, 0), b2, voffB); PG8_STAGE(PG8_SB(0, 1), b2 + hstep, voffB); PG8_STAGE(PG8_SA(0, 0), a2, voffA);
            PG8_WAIT_V(8); PG8_WAIT_L(0); PG8_BAR; PG8_MMA(1, 0, At, B0); PG8_MMA(1, 1, At, B1); PG8_BAR; PG8_SCHED;
            PG8_LDB(B0, 1, 0); PG8_LDB(B1, 1, 1); PG8_SCHED; PG8_LDA(At, 1, 0); PG8_STAGE(PG8_SA(0, 1), a2 + hstep, voffA);
            PG8_WAIT_V(8); PG8_WAIT_L(0); PG8_BAR; PG8_MMA(0, 0, At, B0); PG8_MMA(0, 1, At, B1); PG8_BAR; PG8_SCHED;
            PG8_LDA(At, 1, 1); PG8_STAGE(PG8_SB(1, 0), b3, voffB); PG8_STAGE(PG8_SB(1, 1), b3 + hstep, voffB); PG8_STAGE(PG8_SA(1, 0), a3, voffA);
            PG8_WAIT_V(8); PG8_WAIT_L(0); PG8_BAR; PG8_MMA(1, 0, At, B0); PG8_MMA(1, 1, At, B1); PG8_BAR; PG8_SCHED;
            } else {
            PG8_LDB(B0, 0, 0); PG8_SCHED; PG8_LDA(At, 0, 0); PG8_STAGE(PG8_SA(1, 1), a1 + hstep, voffA);
            PG8_WAIT_L(8); PG8_BAR; PG8_WAIT_L(0); PG8_MMA(0, 0, At, B0); PG8_BAR; PG8_SCHED;
            PG8_LDB(B1, 0, 1); PG8_STAGE(PG8_SB(0, 0), b2, voffB);
            PG8_BAR; PG8_WAIT_L(0); PG8_MMA(0, 1, At, B1); PG8_BAR;
            PG8_LDA(At, 0, 1); PG8_STAGE(PG8_SA(0, 0), a2, voffA);
            PG8_BAR; PG8_WAIT_L(0); PG8_MMA(1, 0, At, B0); PG8_BAR; PG8_SCHED;
            PG8_STAGE(PG8_SB(0, 1), b2 + hstep, voffB);
            PG8_WAIT_V(6); PG8_BAR; PG8_MMA(1, 1, At, B1); PG8_BAR;
            PG8_LDB(B0, 1, 0); PG8_SCHED; PG8_LDA(At, 1, 0); PG8_STAGE(PG8_SA(0, 1), a2 + hstep, voffA);
            PG8_WAIT_L(8); PG8_BAR; PG8_WAIT_L(0); PG8_MMA(0, 0, At, B0); PG8_BAR; PG8_SCHED;
            PG8_LDB(B1, 1, 1); PG8_STAGE(PG8_SB(1, 0), b3, voffB);
            PG8_BAR; PG8_WAIT_L(0); PG8_MMA(0, 1, At, B1); PG8_BAR;
            PG8_LDA(At, 1, 1); PG8_STAGE(PG8_SA(1, 0), a3, voffA);
            PG8_BAR; PG8_WAIT_L(0); PG8_MMA(1, 0, At, B0); PG8_BAR; PG8_SCHED;
            PG8_STAGE(PG8_SB(1, 1), b3 + hstep, voffB);
            PG8_WAIT_V(6); PG8_BAR; PG8_MMA(1, 1, At, B1); PG8_BAR;
            }
        }
        if constexpr (ALIGN_EPI) { if (wr == 0) PG8_BAR; }
#ifdef PROBE_EPI2
        if constexpr (!Epi::AFTER_DRAIN) { E(acc, cur, wr, wc, fr, fq); }
#endif
        if constexpr (!Epi::AFTER_DRAIN) { E(acc, cur, wr, wc, fr, fq); S.done(cur); }
        if (!has_next) break;
#pragma unroll
        for (int a = 0; a < 2; ++a)
#pragma unroll
            for (int b = 0; b < 2; ++b)
#pragma unroll
                for (int m = 0; m < 4; ++m)
#pragma unroll
                    for (int n = 0; n < 2; ++n) acc[a][b][m][n] = (f32x4){0.f, 0.f, 0.f, 0.f};
        cur = nxt; cA = nA; cB = nB; ++ui;
        if constexpr (ALIGN_EPI) { if (wr == 1) PG8_BAR; }
    }
    PG8_WAIT_V(0);
    if constexpr (!ALIGN_EPI) { if (wr == 0) PG8_BAR; }
    PG8_BAR;
    if constexpr (Epi::AFTER_DRAIN) { E.fused(acc, cur, wr, wc, fr, fq, lds, wid, lane); S.done(cur); }
#undef PG8_SA
#undef PG8_SB
#undef PG8_STAGE
#undef PG8_LDA
#undef PG8_LDB
#undef PG8_MMA
#undef PG8_WAIT_V
#undef PG8_WAIT_L
#undef PG8_BAR
#undef PG8_SCHED
}
}

#ifndef MK_N_LAUNCHES
#define MK_N_LAUNCHES 1
#endif
constexpr int BATCH = 4, SEQ = 4096, T = BATCH * SEQ, D = 2048, DEPTH = 4, INW = 6144, HD = 128, NH = 8, WA = 1024, QW = 4096;
constexpr int PLE = 256, NEXP = 16384, NKEYS = 128, TOPK = 16, PH = 8;
constexpr float EPS = 1e-6f;
constexpr int NWAVES = 8, NTHREADS = 512;
constexpr int PHASES_PER_LAYER = 10;
constexpr int NPH = 1 + DEPTH * PHASES_PER_LAYER + 1;
constexpr size_t MiB = 1u << 20;
constexpr size_t WS_CTL = 0, CTL_ZERO_BYTES = 1 * MiB;
constexpr size_t WS_WIN = 1 * MiB;
constexpr size_t WS_WOUT = 97 * MiB;
constexpr size_t WS_WQ = 129 * MiB;
constexpr size_t WS_WG = 161 * MiB;
constexpr size_t WS_WP = 193 * MiB;
constexpr size_t WS_ROPE = 197 * MiB;
constexpr size_t WS_SSQ = 199 * MiB;
constexpr size_t WS_IDS = 205 * MiB;
constexpr size_t WS_GATES = 213 * MiB;
constexpr size_t WS_PB = 221 * MiB;
constexpr size_t WS_U = 253 * MiB;
constexpr size_t WS_PART = 381 * MiB;
constexpr size_t WS_V = 509 * MiB;
constexpr size_t WS_AG = 637 * MiB;
constexpr size_t WS_H = 765 * MiB;
constexpr size_t WS_HBA = 893 * MiB;
constexpr size_t WS_HBB = 957 * MiB;
constexpr size_t WS_QKV = 1021 * MiB;
constexpr size_t WS_OAP = 1213 * MiB;
constexpr size_t WS_OBP = 1309 * MiB;
constexpr size_t WS_MIX = 1341 * MiB;
constexpr size_t WS_QR = 1405 * MiB;
constexpr size_t WS_PP = 1469 * MiB;
constexpr size_t WS_VT16 = 1534 * MiB;
constexpr size_t WS_VT1 = 1566 * MiB;
constexpr size_t WS_LSE = 1598 * MiB;
constexpr size_t WS_KT16 = 765 * MiB;
constexpr size_t WS_KT1 = 797 * MiB;
constexpr size_t WS_SKB = 1600 * MiB;
constexpr size_t WS_H8 = 1602 * MiB;
constexpr size_t WS_WG8 = 1634 * MiB;
constexpr size_t WS_HG8 = 1650 * MiB;
constexpr size_t WS_END = 1682 * MiB;
constexpr int CW_BAR = 4096;
constexpr int RING_BYTES = 131072, LDSCTL_OFF = RING_BYTES, MISC_OFF = LDSCTL_OFF + 320, LDS_BYTES = 147456;

#define GAS __attribute__((address_space(1)))
#define LAS __attribute__((address_space(3)))
typedef unsigned short bf16;
typedef unsigned v4u __attribute__((ext_vector_type(4)));
typedef unsigned v2u __attribute__((ext_vector_type(2)));
typedef float f32x4 __attribute__((ext_vector_type(4)));
typedef float f32x2 __attribute__((ext_vector_type(2)));
typedef __bf16 bf16x2_t __attribute__((ext_vector_type(2)));
#define LDS_WAIT() asm volatile("s_waitcnt lgkmcnt(0)" ::: "memory")

__device__ __forceinline__ unsigned f2bf(float f) { unsigned u = __builtin_bit_cast(unsigned, f); return (u + 0x7fffu + ((u >> 16) & 1u)) >> 16; }
__device__ __forceinline__ unsigned pk2(float lo, float hi) { return f2bf(lo) | (f2bf(hi) << 16); }
__device__ __forceinline__ float bflo(unsigned w) { return __builtin_bit_cast(float, w << 16); }
__device__ __forceinline__ float bfhi(unsigned w) { return __builtin_bit_cast(float, w & 0xffff0000u); }
__device__ __forceinline__ float dot2(unsigned a, unsigned b, float c) { return __builtin_amdgcn_fdot2_f32_bf16(__builtin_bit_cast(bf16x2_t, a), __builtin_bit_cast(bf16x2_t, b), c, false); }
__device__ __forceinline__ float wave_sum(float v) {
#pragma unroll
    for (int o = 1; o < 64; o <<= 1) v += __shfl_xor(v, o);
    return v;
}
__device__ __forceinline__ float wave_max(float v) {
#pragma unroll
    for (int o = 1; o < 64; o <<= 1) v = fmaxf(v, __shfl_xor(v, o));
    return v;
}
__device__ __forceinline__ void wave_argmax(float v, int idx, float& bv, int& bi) {
#pragma unroll
    for (int o = 32; o >= 1; o >>= 1) { const float ov = __shfl_xor(v, o); const int oi = __shfl_xor(idx, o); if (ov > v || (ov == v && oi < idx)) { v = ov; idx = oi; } }
    bv = v; bi = idx;
}

#define XB_TMO      128
#define XB_XCNT(j)  (256  + 64 * (j))
#define XB_XSUB(j)  (1280 + 64 * (j))
#define XB_XGEN(j)  (2304 + 64 * (j))
#define XB_TOP      3328
#define XB_TOPGEN   3392
#define XCD_BAR_WORDS 3456
#define XB_SPIN_CAP (1u << 22)
__device__ __forceinline__ unsigned xb_ld(unsigned* p)              { return __hip_atomic_load(p, __ATOMIC_RELAXED, __HIP_MEMORY_SCOPE_AGENT); }
__device__ __forceinline__ unsigned xb_add(unsigned* p, unsigned v) { return __hip_atomic_fetch_add(p, v, __ATOMIC_RELAXED, __HIP_MEMORY_SCOPE_AGENT); }
__device__ __forceinline__ unsigned xb_xcc_id() { return (unsigned)__builtin_amdgcn_s_getreg((3 << 11) | 20) & 0xFu; }
#define XB_SPIN(cond, bar) do { unsigned _sp = 0; while (cond) { __builtin_amdgcn_s_sleep(1); \
    if ((++_sp & 255u) == 0u) { if (xb_ld(&(bar)[XB_TMO])) break; if (_sp > XB_SPIN_CAP) { atomicAdd(&(bar)[XB_TMO], 1u); break; } } } } while (0)
struct XcdBarrier { unsigned* bar; unsigned x; volatile LAS unsigned* st; };
__device__ __forceinline__ XcdBarrier xcd_barrier_post(unsigned* bar, volatile LAS unsigned* st) {
    XcdBarrier b; b.bar = bar; b.x = xb_xcc_id(); b.st = st;
    if (threadIdx.x == 0) (void)xb_add(&bar[XB_XCNT(b.x)], 1u);
    return b;
}
__device__ __forceinline__ void xcd_barrier_complete(unsigned* bar, unsigned x, unsigned& nloc, unsigned& nx) {
    const unsigned G = gridDim.x * gridDim.y * gridDim.z;
    unsigned sum, cnt, mine, sp = 0u;
    for (;;) {
        sum = 0u; cnt = 0u; mine = 0u;
#pragma unroll
        for (unsigned j = 0; j < 16; ++j) { const unsigned c = xb_ld(&bar[XB_XCNT(j)]); sum += c; cnt += (c > 0u) ? 1u : 0u; mine = (j == x) ? c : mine; }
        if (sum == G) break;
        __builtin_amdgcn_s_sleep(1);
        if ((++sp & 255u) == 0u) { if (xb_ld(&bar[XB_TMO])) break; if (sp > XB_SPIN_CAP) { atomicAdd(&bar[XB_TMO], 1u); break; } }
    }
    nloc = mine > 0u ? mine : 1u; nx = cnt > 0u ? cnt : 1u;
}
__device__ __forceinline__ void xcd_barrier(const XcdBarrier& b) {
    asm volatile("s_waitcnt vmcnt(0)" ::: "memory");
    __syncthreads();
    if (threadIdx.x == 0) {
        unsigned* bar = b.bar;
        __builtin_amdgcn_s_waitcnt(0);
        unsigned nloc = b.st[0], nx = b.st[1];
        if (nloc == 0u) { xcd_barrier_complete(bar, b.x, nloc, nx); b.st[0] = nloc; b.st[1] = nx; }
        const unsigned old = xb_add(&bar[XB_XSUB(b.x)], 1u);
        const unsigned gen = old / nloc;
        if (old + 1u == (gen + 1u) * nloc) {
            __builtin_amdgcn_fence(__ATOMIC_RELEASE, "agent");
            asm volatile("s_waitcnt vmcnt(0)" ::: "memory");
            const unsigned og = xb_add(&bar[XB_TOP], 1u);
            const unsigned tg = og / nx;
            if (og + 1u == (tg + 1u) * nx) xb_add(&bar[XB_TOPGEN], 1u);
            else XB_SPIN(xb_ld(&bar[XB_TOPGEN]) == tg, bar);
            __builtin_amdgcn_fence(__ATOMIC_ACQUIRE, "agent");
            xb_add(&bar[XB_XGEN(b.x)], 1u);
            asm volatile("s_waitcnt vmcnt(0)" ::: "memory");
        } else {
            XB_SPIN(xb_ld(&bar[XB_XGEN(b.x)]) == gen, bar);
            __builtin_amdgcn_fence(__ATOMIC_ACQUIRE, "agent");
            asm volatile("s_waitcnt vmcnt(0)" ::: "memory");
        }
    }
    __syncthreads();
}

struct Args { const void* in[17]; float* out; unsigned char* ws; int ph_lo, ph_hi; };
#define CAS __attribute__((address_space(4)))
typedef const unsigned char CAS* kptr_t;
__device__ __forceinline__ kptr_t kargs() { kptr_t k = (kptr_t)__builtin_amdgcn_kernarg_segment_ptr(); asm volatile("" : "+s"(k)); return k; }
__device__ __forceinline__ const void* kin(kptr_t k, int i) { return *(const void* const CAS*)(k + 8 * i); }
__device__ __forceinline__ float* kout(kptr_t k) { return *(float* const CAS*)(k + 136); }
__device__ __forceinline__ unsigned char* kws(kptr_t k) { return *(unsigned char* const CAS*)(k + 144); }
struct Frame {
    LAS unsigned char* lds;
    int tid, lane, wave, G, gw, ngw;
    __device__ __forceinline__ void init(LAS unsigned char* l) { lds = l; int t_ = threadIdx.x, b_ = blockIdx.x, g_ = gridDim.x; asm volatile("" : "+v"(t_), "+s"(b_), "+s"(g_));
        tid = t_; lane = tid & 63; wave = __builtin_amdgcn_readfirstlane(tid >> 6); G = g_; gw = b_ * NWAVES + wave; ngw = G * NWAVES; }
};
#define IN_F(k) ((const float*)kin(KP, k))
#define WSP(type, off) ((type*)(kws(KP) + (off)))
#define P_x IN_F(0)
#define P_p IN_F(1)
#define P_pos ((const int*)kin(KP, 2))
#define P_attn_norm IN_F(3)
#define P_w_in IN_F(4)
#define P_out_norm_a IN_F(5)
#define P_out_norm_b IN_F(6)
#define P_w_out IN_F(7)
#define P_ffn_norm IN_F(8)
#define P_peer_wq IN_F(9)
#define P_peer_sk IN_F(10)
#define P_peer_u IN_F(11)
#define P_peer_v IN_F(12)
#define P_ple_norm IN_F(13)
#define P_ple_gate IN_F(14)
#define P_ple_proj IN_F(15)
#define P_final_norm IN_F(16)
#define P_Wt_in WSP(bf16, WS_WIN)
#define P_Wt_out WSP(bf16, WS_WOUT)
#define P_Wt_q WSP(bf16, WS_WQ)
#define P_Wt_g WSP(bf16, WS_WG)
#define P_Wt_p WSP(bf16, WS_WP)
#define P_ROPEC WSP(float, WS_ROPE)
#define P_ROPES (WSP(float, WS_ROPE) + SEQ * 64)
#define P_SSQ0 WSP(float, WS_SSQ)
#define P_SSQ1 (WSP(float, WS_SSQ) + (size_t)T * 32)
#define P_SSQ2 (WSP(float, WS_SSQ) + (size_t)T * 64)
#define P_IDS WSP(int, WS_IDS)
#define P_GATES WSP(float, WS_GATES)
#define P_PB WSP(bf16, WS_PB)
#define P_U8 WSP(unsigned char, WS_U)
#define P_V8 WSP(unsigned char, WS_V)
#define P_PART WSP(float, WS_PART)
#define P_AG WSP(float, WS_AG)
#define P_HBA WSP(bf16, WS_HBA)
#define P_HBB WSP(bf16, WS_HBB)
#define P_QKV WSP(bf16, WS_QKV)
#define P_OAP WSP(bf16, WS_OAP)
#define P_OBP WSP(bf16, WS_OBP)
#define P_VT16 WSP(bf16, WS_VT16)
#define P_VT1 WSP(bf16, WS_VT1)
#define P_LSE WSP(float, WS_LSE)
#define P_SKB WSP(bf16, WS_SKB)
#define P_H8 WSP(unsigned char, WS_H8)
#define P_WG8 WSP(unsigned char, WS_WG8)
#define P_HG8 WSP(unsigned char, WS_HG8)
#define P_KT16 WSP(bf16, WS_KT16)
#define P_KT1 WSP(bf16, WS_KT1)
#define P_MIX WSP(bf16, WS_MIX)
#define P_QR WSP(bf16, WS_QR)
#define P_PP WSP(bf16, WS_PP)

__device__ __forceinline__ float row_rstd(const float* ssq, int r) {
    const f32x4* sp = (const f32x4*)(ssq + (size_t)r * 32);
    f32x4 s = sp[0];
#pragma unroll
    for (int i = 1; i < 8; ++i) s += sp[i];
    return rsqrtf(((s[0] + s[1]) + (s[2] + s[3])) * (1.f / D) + EPS);
}
__device__ __forceinline__ float row_rstd4(const float* ssq, int r, int fq) {
    const f32x4* sp = (const f32x4*)(ssq + (size_t)r * 32) + 2 * fq;
    const f32x4 s = sp[0] + sp[1];
    float t = (s[0] + s[1]) + (s[2] + s[3]);
    t += __shfl_xor(t, 16); t += __shfl_xor(t, 32);
    return rsqrtf(t * (1.f / D) + EPS);
}
struct EpiInProj {
    static constexpr bool PERM = true, AFTER_DRAIN = false;
    int dummy;
    __device__ __forceinline__ void operator()(const pg8::f32x4 (&acc)[2][2][4][2], const pg8::Unit& u, int wr, int wc, int fr, int fq) const {
        const kptr_t KP = kargs();
        const float* ssq = P_SSQ0; bf16* O = P_QKV; const float* rc = P_ROPEC; const float* rs = P_ROPES; const int* pos = P_pos;
        const int row0 = u.pm * 256 + wr * 64 + fr, col0 = u.pn * 256 + wc * 32 + 8 * fq;
        const bool rope = u.pn < 8, isq = (u.pn < 4) || (u.pn >= 8 && u.pn < 12), isk = !isq;
        const float qs = isq ? 0.08838834764831845f : 1.f;
        const int j0 = 16 * wc + 4 * fq;
#pragma unroll
        for (int ai = 0; ai < 2; ++ai)
#pragma unroll
            for (int m = 0; m < 4; ++m) {
                const int r = row0 + ai * 128 + m * 16;
                const float rq = row_rstd4(ssq, r, fq) * qs;
                f32x4 c4 = (f32x4){1.f, 1.f, 1.f, 1.f}, s4 = (f32x4){0.f, 0.f, 0.f, 0.f};
                if (rope) { const int p = pos[r]; c4 = *(const f32x4*)(rc + (size_t)p * 64 + j0); s4 = *(const f32x4*)(rs + (size_t)p * 64 + j0); }
#pragma unroll
                for (int bj = 0; bj < 2; ++bj) {
                    const f32x4 v0 = acc[ai][bj][m][0] * rq, v1 = acc[ai][bj][m][1] * rq;
                    const f32x4 o0 = v0 * c4 - v1 * s4, o1 = v1 * c4 + v0 * s4;
                    v4u w; w.x = pg8::cvt_pk_bf16(o0[0], o0[1]); w.y = pg8::cvt_pk_bf16(o0[2], o0[3]); w.z = pg8::cvt_pk_bf16(o1[0], o1[1]); w.w = pg8::cvt_pk_bf16(o1[2], o1[3]);
                    if (!isk) *(v4u*)(O + (size_t)r * QW + col0 + bj * 128) = w;
                    else {
                        const int t = r & (SEQ - 1), bh = (r >> 12) * 8 + 2 * (u.pn & 3) + bj, ks = 2 * wc + (fq >> 1);
                        bf16* kd = (u.pn < 8) ? P_KT16 + ((((size_t)bh * 16 + (t & 15)) * 32 + (t >> 7)) * 8 + ks) * 128 + ((t >> 4) & 7) * 16
                                              : P_KT1 + (((size_t)bh * (SEQ / 8) + (t >> 3)) * 8 + ks) * 128 + (t & 7) * 16;
                        *(v4u*)(kd + 8 * (fq & 1)) = w;
                    }
                }
            }
    }
};
struct EpiVa {
    static constexpr bool PERM = true, AFTER_DRAIN = false;
    int dummy;
    __device__ __forceinline__ void operator()(const pg8::f32x4 (&acc)[2][2][4][2], const pg8::Unit& u, int wr, int wc, int fr, int fq) const {
        const kptr_t KP = kargs();
        const float* ssq = P_SSQ0; bf16* VT = P_VT16;
        const int row0 = u.pm * 256 + wr * 64 + fr;
        const int bh0 = (u.pm >> 4) * 8 + 2 * u.pn, chunk0 = (u.pm & 15) << 1;
#pragma unroll
        for (int ai = 0; ai < 2; ++ai) {
            float rstd[4];
#pragma unroll
            for (int m = 0; m < 4; ++m) rstd[m] = row_rstd4(ssq, row0 + ai * 128 + m * 16, fq);
#pragma unroll
            for (int bj = 0; bj < 2; ++bj)
#pragma unroll
                for (int n = 0; n < 2; ++n)
#pragma unroll
                    for (int i = 0; i < 4; ++i) {
                        const int dim = 32 * wc + 8 * fq + 4 * n + i;
                        v2u w; w.x = pg8::cvt_pk_bf16(acc[ai][bj][0][n][i] * rstd[0], acc[ai][bj][1][n][i] * rstd[1]);
                        w.y = pg8::cvt_pk_bf16(acc[ai][bj][2][n][i] * rstd[2], acc[ai][bj][3][n][i] * rstd[3]);
                        *(v2u*)(VT + ((((size_t)(bh0 + bj) * 16 + fr) * 32 + chunk0 + ai) * 128 + dim) * 8 + 4 * wr) = w;
                    }
        }
    }
};
struct EpiVbT {
    static constexpr bool PERM = true, AFTER_DRAIN = false;
    int dummy;
    __device__ __forceinline__ void operator()(const pg8::f32x4 (&acc)[2][2][4][2], const pg8::Unit& u, int wr, int wc, int fr, int fq) const {
        const kptr_t KP = kargs();
        const float* ssq = P_SSQ0; bf16* VT = P_VT1;
        const int row0 = u.pm * 256 + wr * 64 + fr, col0 = u.pn * 256 + wc * 32 + 8 * fq;
#pragma unroll
        for (int bj = 0; bj < 2; ++bj) {
            const int c = col0 + bj * 128, b = c >> 12, t = c & (SEQ - 1);
            float rs[8];
            { const f32x4* sp = (const f32x4*)(ssq + (size_t)(c + (fr & 7)) * 32) + 4 * (fr >> 3);
              const f32x4 s4 = (sp[0] + sp[1]) + (sp[2] + sp[3]);
              float tt = (s4[0] + s4[1]) + (s4[2] + s4[3]); tt += __shfl_xor(tt, 8);
              const float rv = rsqrtf(tt * (1.f / D) + EPS);
              const int lb_ = (fq << 4);
#pragma unroll
              for (int i = 0; i < 8; ++i) rs[i] = __shfl(rv, lb_ + i); }
#pragma unroll
            for (int ai = 0; ai < 2; ++ai)
#pragma unroll
                for (int m = 0; m < 4; ++m) {
                    const int r = row0 + ai * 128 + m * 16;
                    const f32x4 v0 = acc[ai][bj][m][0], v1 = acc[ai][bj][m][1];
                    v4u w; w.x = pg8::cvt_pk_bf16(v0[0] * rs[0], v0[1] * rs[1]); w.y = pg8::cvt_pk_bf16(v0[2] * rs[2], v0[3] * rs[3]);
                    w.z = pg8::cvt_pk_bf16(v1[0] * rs[4], v1[1] * rs[5]); w.w = pg8::cvt_pk_bf16(v1[2] * rs[6], v1[3] * rs[7]);
                    *(v4u*)(VT + (((size_t)(b * 8 + (r >> 7)) * (SEQ / 8) + (t >> 3)) * 128 + (r & 127)) * 8) = w;
                }
        }
    }
};
struct EpiBf16Scale {
    static constexpr bool PERM = true, AFTER_DRAIN = false;
    int which;
    __device__ __forceinline__ void operator()(const pg8::f32x4 (&acc)[2][2][4][2], const pg8::Unit& u, int wr, int wc, int fr, int fq) const {
        const kptr_t KP = kargs();
        bf16* O = which == 0 ? P_QR : P_PP; const int ldc = D; const float* ssq = which == 0 ? P_SSQ1 : nullptr;
        const int row0 = u.pm * 256 + wr * 64 + fr, col0 = u.pn * 256 + wc * 32 + 8 * fq;
#pragma unroll
        for (int ai = 0; ai < 2; ++ai)
#pragma unroll
            for (int m = 0; m < 4; ++m) {
                const int r = row0 + ai * 128 + m * 16;
                const float rstd = ssq ? row_rstd4(ssq, r, fq) : 1.f;
#pragma unroll
                for (int bj = 0; bj < 2; ++bj) {
                    const f32x4 o0 = acc[ai][bj][m][0] * rstd, o1 = acc[ai][bj][m][1] * rstd;
                    if (which == 1) {
                        int w0 = __builtin_amdgcn_cvt_pk_fp8_f32(o0[0], o0[1], 0, false); w0 = __builtin_amdgcn_cvt_pk_fp8_f32(o0[2], o0[3], w0, true);
                        int w1 = __builtin_amdgcn_cvt_pk_fp8_f32(o1[0], o1[1], 0, false); w1 = __builtin_amdgcn_cvt_pk_fp8_f32(o1[2], o1[3], w1, true);
                        *(v2u*)((unsigned char*)O + (size_t)r * ldc + col0 + bj * 128) = (v2u){(unsigned)w0, (unsigned)w1};
                    } else {
                    v4u w; w.x = pg8::cvt_pk_bf16(o0[0], o0[1]); w.y = pg8::cvt_pk_bf16(o0[2], o0[3]); w.z = pg8::cvt_pk_bf16(o1[0], o1[1]); w.w = pg8::cvt_pk_bf16(o1[2], o1[3]);
                    *(v4u*)(O + (size_t)r * ldc + col0 + bj * 128) = w; }
                }
            }
    }
};
constexpr float XS4 = 1.0f;
template <int MODE> struct EpiResid {
    static constexpr bool PERM = true, AFTER_DRAIN = false;
    int dummy;
    __device__ __forceinline__ void operator()(const pg8::f32x4 (&acc)[2][2][4][2], const pg8::Unit& u, int wr, int wc, int fr, int fq) const {
        const kptr_t KP = kargs();
        const bf16* HI = MODE == 0 ? P_HBB : P_HBA; bf16* HO = MODE == 0 ? P_HBA : P_HBB; float* ssq_out = MODE == 0 ? P_SSQ1 : P_SSQ0; const float* ssq_in = P_SSQ2; const bf16* PP = P_PP;
        const int row0 = u.pm * 256 + wr * 64 + fr, col0 = u.pn * 256 + wc * 32 + 8 * fq;
#pragma unroll
        for (int ai = 0; ai < 2; ++ai)
#pragma unroll
            for (int m = 0; m < 4; ++m) {
                const int r = row0 + ai * 128 + m * 16;
                float rstd = 1.f; if (MODE == 1) rstd = row_rstd4(ssq_in, r, fq);
                float ss = 0.f;
#pragma unroll
                for (int bj = 0; bj < 2; ++bj) {
                    const size_t off = (size_t)r * D + col0 + bj * 128;
                    const v4u hw = *(const v4u*)(HI + off);
                    f32x4 a0 = acc[ai][bj][m][0], a1 = acc[ai][bj][m][1];
                    if (MODE == 1) {
                        const v2u pw = *(const v2u*)((const unsigned char*)PP + off);
                        const f32x2 pa = __builtin_amdgcn_cvt_pk_f32_fp8((int)pw.x, false), pb = __builtin_amdgcn_cvt_pk_f32_fp8((int)pw.x, true), pc = __builtin_amdgcn_cvt_pk_f32_fp8((int)pw.y, false), pd = __builtin_amdgcn_cvt_pk_f32_fp8((int)pw.y, true);
                        const f32x4 p0 = (f32x4){pa.x, pa.y, pb.x, pb.y}, p1 = (f32x4){pc.x, pc.y, pd.x, pd.y};
#pragma unroll
                        for (int i = 0; i < 4; ++i) { a0[i] = p0[i] * __builtin_amdgcn_rcpf(1.f + __expf(-a0[i] * rstd)); a1[i] = p1[i] * __builtin_amdgcn_rcpf(1.f + __expf(-a1[i] * rstd)); }
                    }
                    const f32x4 h0 = (f32x4){bflo(hw.x), bfhi(hw.x), bflo(hw.y), bfhi(hw.y)} + a0, h1 = (f32x4){bflo(hw.z), bfhi(hw.z), bflo(hw.w), bfhi(hw.w)} + a1;
                    v4u ow; ow.x = pg8::cvt_pk_bf16(h0[0], h0[1]); ow.y = pg8::cvt_pk_bf16(h0[2], h0[3]); ow.z = pg8::cvt_pk_bf16(h1[0], h1[1]); ow.w = pg8::cvt_pk_bf16(h1[2], h1[3]);
                    *(v4u*)(HO + off) = ow;
                    const f32x4 q0 = (f32x4){bflo(ow.x), bfhi(ow.x), bflo(ow.y), bfhi(ow.y)}, q1 = (f32x4){bflo(ow.z), bfhi(ow.z), bflo(ow.w), bfhi(ow.w)};
                    if (MODE == 0) {
                        unsigned w4 = 0u;
                        w4 = __builtin_amdgcn_cvt_scalef32_pk_fp4_f32(w4, q0[0] * XS4, q0[1] * XS4, 1.0f, 0); w4 = __builtin_amdgcn_cvt_scalef32_pk_fp4_f32(w4, q0[2] * XS4, q0[3] * XS4, 1.0f, 1);
                        w4 = __builtin_amdgcn_cvt_scalef32_pk_fp4_f32(w4, q1[0] * XS4, q1[1] * XS4, 1.0f, 2); w4 = __builtin_amdgcn_cvt_scalef32_pk_fp4_f32(w4, q1[2] * XS4, q1[3] * XS4, 1.0f, 3);
                        *(unsigned*)(P_H8 + (off >> 1)) = w4; }
                    ss += ((q0[0] * q0[0] + q0[1] * q0[1]) + (q0[2] * q0[2] + q0[3] * q0[3])) + ((q1[0] * q1[0] + q1[1] * q1[1]) + (q1[2] * q1[2] + q1[3] * q1[3]));
                }
                ss += __shfl_xor(ss, 16); ss += __shfl_xor(ss, 32);
                if (fq == 0) ssq_out[(size_t)r * 32 + u.pn * 4 + wc] = ss;
            }
    }
};
struct EpiNull { static constexpr bool PERM = true, AFTER_DRAIN = false; int dummy;
    __device__ __forceinline__ void operator()(const pg8::f32x4 (&acc)[2][2][4][2], const pg8::Unit& u, int wr, int wc, int fr, int fq) const {
        float s = 0.f;
#pragma unroll
        for (int ai = 0; ai < 2; ++ai)
#pragma unroll
            for (int bj = 0; bj < 2; ++bj)
#pragma unroll
                for (int m = 0; m < 4; ++m)
#pragma unroll
                    for (int n = 0; n < 2; ++n) s += acc[ai][bj][m][n][0] + acc[ai][bj][m][n][1] + acc[ai][bj][m][n][2] + acc[ai][bj][m][n][3];
        if (s == 1.2345e-30f) { const kptr_t KP = kargs(); P_LSE[0] = s; }
    }
};
__device__ __forceinline__ int inproj_src_col(int c) {
    if (c >= 5120) return c;
    if (c >= 4096) return c - 2048;
    if (c >= 2048) return c + 1024;
    const int head = c >> 7, p = c & 127, wc = p >> 5, fq = (p >> 3) & 3, n = (p >> 2) & 1, i = p & 3;
    return head * 128 + 64 * n + 16 * wc + 4 * fq + i;
}
typedef short v2s_t __attribute__((ext_vector_type(2)));
__device__ __forceinline__ void transpose_item(const float* W, int K, int N, bf16* WT, const float* gain, bool perm, LAS float* scr, int item, int lane, unsigned char* W8 = nullptr) {
    const int nblk = N / 32, kb = item / nblk, nb = item % nblk, k0 = 64 * kb, n0 = 32 * nb;
    const int cs = perm ? inproj_src_col(n0 + (lane & 31)) : n0 + (lane & 31);
    float vals[32];
#pragma unroll
    for (int i = 0; i < 32; ++i) { const int kk = 2 * i + (lane >> 5); const float g = gain ? gain[k0 + kk] : 1.f; vals[i] = W[(size_t)(k0 + kk) * N + cs] * g; }
#pragma unroll
    for (int i = 0; i < 32; ++i) scr[(2 * i + (lane >> 5)) * 33 + (lane & 31)] = vals[i];
    LDS_WAIT(); asm volatile("" ::: "memory");
    const int c = lane & 7;
#pragma unroll
    for (int j = 0; j < 4; ++j) { const int n = (lane >> 3) + 8 * j; const LAS float* s = scr + (8 * c) * 33 + n;
        v4u o; o.x = pk2(s[0 * 33], s[1 * 33]); o.y = pk2(s[2 * 33], s[3 * 33]); o.z = pk2(s[4 * 33], s[5 * 33]); o.w = pk2(s[6 * 33], s[7 * 33]);
        if (!W8) *(v4u*)(WT + (size_t)(n0 + n) * K + k0 + 8 * c) = o;
        if (W8) {
            v2s_t w0 = (v2s_t){0, 0}, w1 = (v2s_t){0, 0};
            w0 = __builtin_amdgcn_cvt_scalef32_pk_fp8_f32(w0, s[0 * 33] * 64.f, s[1 * 33] * 64.f, 1.0f, false); w0 = __builtin_amdgcn_cvt_scalef32_pk_fp8_f32(w0, s[2 * 33] * 64.f, s[3 * 33] * 64.f, 1.0f, true);
            w1 = __builtin_amdgcn_cvt_scalef32_pk_fp8_f32(w1, s[4 * 33] * 64.f, s[5 * 33] * 64.f, 1.0f, false); w1 = __builtin_amdgcn_cvt_scalef32_pk_fp8_f32(w1, s[6 * 33] * 64.f, s[7 * 33] * 64.f, 1.0f, true);
            *(v2u*)(W8 + (size_t)(n0 + n) * K + k0 + 8 * c) = (v2u){__builtin_bit_cast(unsigned, w0), __builtin_bit_cast(unsigned, w1)}; } }
    LDS_WAIT(); asm volatile("" ::: "memory");
}
constexpr float USCALE = 88.f, VSCALE = 5.5f;
__device__ __forceinline__ void p_prologue(LAS unsigned char* lds_) {
    Frame F; F.init(lds_); const kptr_t KP = kargs();
    LAS float* scr = (LAS float*)(F.lds + F.wave * 16384);
    constexpr int I_IN = (D / 64) * (INW / 32), I_SQ = (D / 64) * (D / 32), I_P = (PLE / 64) * (D / 32);
    constexpr int PER_LAYER = I_IN + 3 * I_SQ + I_P;
    for (int it = F.gw; it < DEPTH * PER_LAYER; it += F.ngw) {
        const int l = it / PER_LAYER; int r = it % PER_LAYER;
        if (r < I_IN) { transpose_item(P_w_in + (size_t)l * D * INW, D, INW, P_Wt_in + (size_t)l * INW * D, P_attn_norm + l * D, true, scr, r, F.lane); continue; } r -= I_IN;
        if (r < I_SQ) {
            const int kb = r / (D / 32), k0 = 64 * kb;
            const float* g = (k0 < WA) ? (P_out_norm_a + l * WA) : (P_out_norm_b + l * WA - WA);
            transpose_item(P_w_out + (size_t)l * D * D, D, D, P_Wt_out + (size_t)l * D * D, g, false, scr, r, F.lane); continue; } r -= I_SQ;
        if (r < I_SQ) { transpose_item(P_peer_wq + (size_t)l * D * D, D, D, P_Wt_q + (size_t)l * D * D, P_ffn_norm + l * D, false, scr, r, F.lane); continue; } r -= I_SQ;
        if (r < I_SQ) { transpose_item(P_ple_gate + (size_t)l * D * D, D, D, P_Wt_g + (size_t)l * D * D, P_ple_norm + l * D, false, scr, r, F.lane, P_WG8 + (size_t)l * D * D); continue; } r -= I_SQ;
        transpose_item(P_ple_proj + (size_t)l * PLE * D, PLE, D, P_Wt_p + (size_t)l * D * PLE, nullptr, false, scr, r, F.lane);
    }
    const size_t gt = (size_t)blockIdx.x * NTHREADS + F.tid, ngt = (size_t)F.G * NTHREADS;
    for (size_t i0 = gt; i0 < (size_t)DEPTH * NEXP * D / 8; i0 += 4 * ngt) {
        f32x4 ua[4], ub[4], va[4], vb[4]; size_t e0[4];
#pragma unroll
        for (int q = 0; q < 4; ++q) { const size_t i = (i0 + q * ngt < (size_t)DEPTH * NEXP * D / 8) ? i0 + q * ngt : i0; e0[q] = i * 8;
            ua[q] = *(const f32x4*)(P_peer_u + e0[q]); ub[q] = *(const f32x4*)(P_peer_u + e0[q] + 4); va[q] = *(const f32x4*)(P_peer_v + e0[q]); vb[q] = *(const f32x4*)(P_peer_v + e0[q] + 4); }
#pragma unroll
        for (int q = 0; q < 4; ++q) {
            const int l = (int)(e0[q] / ((size_t)NEXP * D)), d0 = (int)(e0[q] % D);
            const f32x4 ga = *(const f32x4*)(P_ffn_norm + l * D + d0) * USCALE, gb = *(const f32x4*)(P_ffn_norm + l * D + d0 + 4) * USCALE;
            const f32x4 a = ua[q], b = ub[q];
            const size_t sv = ((size_t)(l * 8 + (d0 >> 8)) * NEXP + (e0[q] / D) % NEXP) * 128 + ((d0 & 255) >> 1);
            unsigned uo = 0u;
            uo = __builtin_amdgcn_cvt_scalef32_pk_fp4_f32(uo, a[0] * ga[0], a[1] * ga[1], 1.0f, 0); uo = __builtin_amdgcn_cvt_scalef32_pk_fp4_f32(uo, a[2] * ga[2], a[3] * ga[3], 1.0f, 1);
            uo = __builtin_amdgcn_cvt_scalef32_pk_fp4_f32(uo, b[0] * gb[0], b[1] * gb[1], 1.0f, 2); uo = __builtin_amdgcn_cvt_scalef32_pk_fp4_f32(uo, b[2] * gb[2], b[3] * gb[3], 1.0f, 3);
            *(unsigned*)(P_U8 + sv) = uo;
            const f32x4 c = va[q] * VSCALE, d = vb[q] * VSCALE;
            unsigned qq = 0u;
            qq = __builtin_amdgcn_cvt_scalef32_pk_fp4_f32(qq, c[0], c[1], 1.0f, 0); qq = __builtin_amdgcn_cvt_scalef32_pk_fp4_f32(qq, c[2], c[3], 1.0f, 1);
            qq = __builtin_amdgcn_cvt_scalef32_pk_fp4_f32(qq, d[0], d[1], 1.0f, 2); qq = __builtin_amdgcn_cvt_scalef32_pk_fp4_f32(qq, d[2], d[3], 1.0f, 3);
            *(unsigned*)(P_V8 + sv) = qq;
        }
    }
    for (size_t i = gt; i < (size_t)DEPTH * PH * 2 * NKEYS * 128 / 8; i += ngt) {
        const size_t e0 = i * 8;
        const f32x4 a = *(const f32x4*)(P_peer_sk + e0), b = *(const f32x4*)(P_peer_sk + e0 + 4);
        v4u o; o.x = pk2(a[0], a[1]); o.y = pk2(a[2], a[3]); o.z = pk2(b[0], b[1]); o.w = pk2(b[2], b[3]);
        *(v4u*)(P_SKB + e0) = o;
    }
    for (size_t i0 = gt; i0 < (size_t)DEPTH * T * PLE / 8; i0 += 4 * ngt) {
        f32x4 a[4], b[4]; size_t e0[4];
#pragma unroll
        for (int q = 0; q < 4; ++q) { const size_t i = (i0 + q * ngt < (size_t)DEPTH * T * PLE / 8) ? i0 + q * ngt : i0; e0[q] = i * 8; a[q] = *(const f32x4*)(P_p + e0[q]); b[q] = *(const f32x4*)(P_p + e0[q] + 4); }
#pragma unroll
        for (int q = 0; q < 4; ++q) { v4u o; o.x = pk2(a[q][0], a[q][1]); o.y = pk2(a[q][2], a[q][3]); o.z = pk2(b[q][0], b[q][1]); o.w = pk2(b[q][2], b[q][3]);
            *(v4u*)(P_PB + e0[q]) = o; }
    }
    for (size_t i = gt; i < (size_t)SEQ * 64; i += ngt) {
        const int pos = (int)(i >> 6), j = (int)(i & 63);
        const float inv = powf(10000.f, -(float)j / 64.f);
        const float ang = (float)pos * inv;
        const double rev = (double)ang * 0.15915494309189535;
        const float fr = (float)(rev - rint(rev));
        P_ROPEC[i] = __builtin_amdgcn_cosf(fr); P_ROPES[i] = __builtin_amdgcn_sinf(fr);
    }
    if (blockIdx.x == 0 && F.tid < 256) ((unsigned*)(kws(KP) + WS_VT16 - 1024))[F.tid] = 0u;
    for (int t = F.gw; t < T; t += F.ngw) {
        const f32x4* xr = (const f32x4*)(P_x + (size_t)t * D) + F.lane * 2;
        float ss = 0.f;
#pragma unroll
        for (int j = 0; j < 4; ++j) {
            const f32x4 a = xr[j * 128], b = xr[j * 128 + 1];
            const size_t off = (size_t)t * D + j * 512 + F.lane * 8;
            v4u o; o.x = pk2(a[0], a[1]); o.y = pk2(a[2], a[3]); o.z = pk2(b[0], b[1]); o.w = pk2(b[2], b[3]);
            *(v4u*)(P_HBB + off) = o;
            ss += (a[0] * a[0] + a[1] * a[1]) + (a[2] * a[2] + a[3] * a[3]) + (b[0] * b[0] + b[1] * b[1]) + (b[2] * b[2] + b[3] * b[3]);
        }
        ss = wave_sum(ss);
        if (F.lane < 32) P_SSQ0[(size_t)t * 32 + F.lane] = (F.lane == 0) ? ss : 0.f;
    }
}

typedef short bf16x8 __attribute__((ext_vector_type(8)));
typedef short bf16x8u __attribute__((ext_vector_type(8), aligned(4)));
typedef float f32x16 __attribute__((ext_vector_type(16)));
#define MFMA32(a, b, c) __builtin_amdgcn_mfma_f32_32x32x16_bf16((a), (b), (c), 0, 0, 0)
constexpr int OT_ROW = 272, OT_BYTES = 32 * OT_ROW;
__device__ __forceinline__ int keymap(int r) { return (r & 0x13) | ((r & 8) >> 1) | ((r & 4) << 1); }
__device__ __forceinline__ bf16x8 pack8(const float* p) { v4u w; w.x = pg8::cvt_pk_bf16(p[0], p[1]); w.y = pg8::cvt_pk_bf16(p[2], p[3]); w.z = pg8::cvt_pk_bf16(p[4], p[5]); w.w = pg8::cvt_pk_bf16(p[6], p[7]); return __builtin_bit_cast(bf16x8, w); }
__device__ __forceinline__ void chunk_of(int pat, int j, int q, int P0, int r, int gi, int& cls, int& ps) {
    if (pat == 0) { const int cidx = 4 * j + q; cls = cidx >> 1; ps = (P0 & ~7) + 8 * (cidx & 1); }
    else {
        const int A = gi - (gi - j + 5) % 5;
        if (pat == 1) { cls = 4 * q + r; ps = 8 * A; } else { cls = r; ps = 32 * A + 8 * q; }
    }
}
__device__ __forceinline__ void p_attn_dilated(LAS unsigned char* lds_) {
    Frame F; F.init(lds_); const kptr_t KP = kargs();
    const bf16* QKV = P_QKV; const bf16* VT = P_VT16; const bf16* KT = P_KT16; bf16* OAP = P_OAP; float* LSE = P_LSE;
    const int n = F.lane & 31, hh = F.lane >> 5, kap = keymap(n);
#if defined(PROBE_DILH1)
    if (F.wave >= 4) return;
    for (int item = (F.gw / NWAVES) * 4 + F.wave; item < BATCH * NH * 3 * 128; item += F.G * 4) {
#elif defined(PROBE_DILH2)
    if (F.wave & 2) return;
    for (int item = (F.gw / NWAVES) * 4 + (F.wave & 1) + 2 * (F.wave >> 2); item < BATCH * NH * 3 * 128; item += F.G * 4) {
#else
    for (int item = F.gw; item < BATCH * NH * 3 * 128; item += F.ngw) {
#endif
        const int g = item & 127, pat = (item >> 7) % 3, bh = item / 384, h = bh & 7, b = bh >> 3;
        int d, qbase, ntiles, r = 0, P0, gi = 0;
        if (pat == 0) { d = 1; qbase = 32 * g; ntiles = 8; P0 = 2 * g - 8; }
        else if (pat == 1) { d = 4; r = g >> 5; gi = g & 31; qbase = 128 * gi + r; ntiles = 5; P0 = 8 * gi - 32; }
        else { d = 16; r = g >> 3; gi = g & 7; qbase = 512 * gi + r; ntiles = 5; P0 = 32 * gi - 128; }
        const int tq = qbase + n * d;
        bf16x8 qf[8];
        { const bf16* qp = QKV + (size_t)(b * SEQ + tq) * QW + h * HD + 8 * hh;
#pragma unroll
          for (int s = 0; s < 8; ++s) qf[s] = *(const bf16x8*)(qp + 16 * s); }
        f32x16 o[4];
#pragma unroll
        for (int dt = 0; dt < 4; ++dt)
#pragma unroll
            for (int i = 0; i < 16; ++i) o[dt][i] = 0.f;
        float m = -3.0e38f, l = 0.f;
        bf16x8 kn[8];
#define DA_KLOAD(j_) do { int cls_, ps_; chunk_of(pat, (j_), kap >> 3, P0, r, gi, cls_, ps_); \
            const bf16* kp_ = KT + ((((size_t)bh * 16 + cls_) * 32 + (max(ps_, 0) >> 3)) * 8) * 128 + (kap & 7) * 16 + 8 * hh; \
            _Pragma("unroll") for (int s_ = 0; s_ < 8; ++s_) kn[s_] = *(const bf16x8*)(kp_ + 128 * s_); } while (0)
        DA_KLOAD(0);
        for (int j = 0; j < ntiles; ++j) {
            if (pat != 0 && gi - (gi - j + 5) % 5 < 0) { if (j + 1 < ntiles) DA_KLOAD(j + 1); continue; }
            int ccls[2], cps[2];
            chunk_of(pat, j, hh, P0, r, gi, ccls[0], cps[0]); chunk_of(pat, j, 2 + hh, P0, r, gi, ccls[1], cps[1]);
            bf16x8 vf[2][4];
#define DA_VLOAD(sp_) do { const bf16* vp_ = VT + ((((size_t)bh * 16 + ccls[sp_]) * 32 + (max(cps[sp_], 0) >> 3)) * 128 + n) * 8; \
            _Pragma("unroll") for (int dt_ = 0; dt_ < 4; ++dt_) vf[sp_][dt_] = *(const bf16x8*)(vp_ + dt_ * 32 * 8); } while (0)
            DA_VLOAD(0);
            f32x16 S;
#pragma unroll
            for (int i = 0; i < 16; ++i) S[i] = 0.f;
#pragma unroll
            for (int s = 0; s < 8; ++s) S = MFMA32(kn[s], qf[s], S);
            asm volatile("" ::: "memory");
            DA_VLOAD(1);
            if (j + 1 < ntiles) DA_KLOAD(j + 1);
            float pv[16]; float tmax = -3.0e38f;
#pragma unroll
            for (int i = 0; i < 16; ++i) { const int sp = i >> 3, pos = cps[sp] + (i & 7), tk = 16 * pos + ccls[sp];
                const bool ok = (pos >= 0) && (tk <= tq) && (tq - tk <= 128 * d);
                pv[i] = ok ? S[i] : -3.0e38f; tmax = fmaxf(tmax, pv[i]); }
            tmax = fmaxf(tmax, __shfl_xor(tmax, 32));
            if (__any(tmax > m + 8.f)) {
                const float mn = fmaxf(m, tmax), alpha = __expf(m - mn);
                l *= alpha; m = mn;
#pragma unroll
                for (int dt = 0; dt < 4; ++dt)
#pragma unroll
                    for (int i = 0; i < 16; ++i) o[dt][i] *= alpha;
            }
            float ps_ = 0.f;
#pragma unroll
            for (int i = 0; i < 16; ++i) { pv[i] = (pv[i] > -1.0e38f) ? __expf(pv[i] - m) : 0.f; ps_ += pv[i]; }
            l += ps_;
#pragma unroll
            for (int sp = 0; sp < 2; ++sp) {
                const bf16x8 pf = pack8(pv + 8 * sp);
#pragma unroll
                for (int dt = 0; dt < 4; ++dt) o[dt] = MFMA32(vf[sp][dt], pf, o[dt]);
            }
        }
#undef DA_KLOAD
#undef DA_VLOAD
        const float lt = l + __shfl_xor(l, 32), il = 1.f / lt;
        { LAS unsigned char* st = F.lds + F.wave * OT_BYTES;
#pragma unroll
          for (int dt = 0; dt < 4; ++dt)
#pragma unroll
              for (int q4 = 0; q4 < 4; ++q4) { v2u ww; ww.x = pk2(o[dt][4 * q4] * il, o[dt][4 * q4 + 1] * il); ww.y = pk2(o[dt][4 * q4 + 2] * il, o[dt][4 * q4 + 3] * il);
                  *(LAS v2u*)(st + n * OT_ROW + (32 * dt + 8 * q4 + 4 * hh) * 2) = ww; }
#pragma unroll
          for (int k = 0; k < 8; ++k) { const int row = 4 * k + (F.lane >> 4);
              const v4u x = *(const LAS v4u*)(st + row * OT_ROW + (F.lane & 15) * 16);
              *(v4u*)(OAP + ((size_t)pat * T + b * SEQ + qbase + row * d) * WA + h * HD + (F.lane & 15) * 8) = x; } }
        if (hh == 0) LSE[((size_t)pat * T + b * SEQ + tq) * 8 + h] = m + __logf(lt);
    }
}
#ifndef STK_THR
#define STK_THR -17.5f
#endif
__device__ __forceinline__ void p_attn_stick(LAS unsigned char* lds_) {
    Frame F; F.init(lds_); const kptr_t KP = kargs();
    const bf16* QKV = P_QKV; const bf16* VT = P_VT1; const bf16* KT = P_KT1; bf16* OBP = P_OBP;
    const int n = F.lane & 31, hh = F.lane >> 5, kap = keymap(n);
    for (int item = F.gw; item < BATCH * NH * 128; item += F.ngw) {
        const int qb = item & 127, bh = item >> 7, h = bh & 7, b = bh >> 3, q0 = 32 * qb, tq = q0 + n;
        bf16x8 qf[8];
        { const bf16* qp = QKV + (size_t)(b * SEQ + tq) * QW + 2048 + h * HD + 8 * hh;
#pragma unroll
          for (int s = 0; s < 8; ++s) qf[s] = *(const bf16x8*)(qp + 16 * s); }
        f32x16 o[4];
#pragma unroll
        for (int dt = 0; dt < 4; ++dt)
#pragma unroll
            for (int i = 0; i < 16; ++i) o[dt][i] = 0.f;
        float carry = 0.f;
        bf16x8 kn[8];
        { const bf16* kp = KT + (((size_t)bh * (SEQ / 8) + ((q0 + kap) >> 3)) * 8) * 128 + (kap & 7) * 16 + 8 * hh;
#pragma unroll
          for (int s = 0; s < 8; ++s) kn[s] = *(const bf16x8*)(kp + 128 * s); }
        for (int kb = q0; kb >= 0; kb -= 32) {
            bf16x8 vf[2][4];
#define SB_VLOAD(sp_) do { const bf16* vp_ = VT + (((size_t)bh * (SEQ / 8) + ((kb + 16 * (sp_) + 8 * hh) >> 3)) * 128 + n) * 8; \
            _Pragma("unroll") for (int dt_ = 0; dt_ < 4; ++dt_) vf[sp_][dt_] = *(const bf16x8*)(vp_ + dt_ * 32 * 8); } while (0)
            SB_VLOAD(0);
            f32x16 S;
#pragma unroll
            for (int i = 0; i < 16; ++i) S[i] = 0.f;
#pragma unroll
            for (int s = 0; s < 8; ++s) S = MFMA32(kn[s], qf[s], S);
            asm volatile("" ::: "memory");
            SB_VLOAD(1);
            { const bf16* kp = KT + (((size_t)bh * (SEQ / 8) + ((max(kb - 32, 0) + kap) >> 3)) * 8) * 128 + (kap & 7) * 16 + 8 * hh;
#pragma unroll
                for (int s = 0; s < 8; ++s) kn[s] = *(const bf16x8*)(kp + 128 * s); }
            float lm[16], av[16]; float B0 = 0.f, B1 = 0.f;
#pragma unroll
            for (int i = 0; i < 16; ++i) { const int tk = kb + 16 * (i >> 3) + 8 * hh + (i & 7); const float z = S[i];
                lm[i] = (tk < tq) ? -(fmaxf(z, 0.f) + __logf(1.f + __expf(-fabsf(z)))) : 0.f;
                if (i < 8) B0 += lm[i]; else B1 += lm[i]; }
            const float PB0 = __shfl_xor(B0, 32), PB1 = __shfl_xor(B1, 32);
            const float base1 = hh ? 0.f : PB1, base0 = hh ? (B1 + PB1) : (PB1 + B1 + PB0);
            float run = 0.f;
#pragma unroll
            for (int e = 7; e >= 0; --e) { const int i = 8 + e; const int tk = kb + 16 + 8 * hh + e;
                av[i] = (tk < tq) ? __expf(S[i] + lm[i] + (carry + base1 + run)) : 0.f; run += lm[i]; }
            run = 0.f;
#pragma unroll
            for (int e = 7; e >= 0; --e) { const int i = e; const int tk = kb + 8 * hh + e;
                av[i] = (tk < tq) ? __expf(S[i] + lm[i] + (carry + base0 + run)) : 0.f; run += lm[i]; }
            carry += (B0 + B1) + (PB0 + PB1);
#pragma unroll
            for (int sp = 0; sp < 2; ++sp) {
                const bf16x8 pf = pack8(av + 8 * sp);
#pragma unroll
                for (int dt = 0; dt < 4; ++dt) o[dt] = MFMA32(vf[sp][dt], pf, o[dt]);
            }
            if (__all(carry < STK_THR)) break;
        }
        { LAS unsigned char* st = F.lds + F.wave * OT_BYTES;
#pragma unroll
          for (int dt = 0; dt < 4; ++dt)
#pragma unroll
              for (int q4 = 0; q4 < 4; ++q4) { v2u w; w.x = pk2(o[dt][4 * q4], o[dt][4 * q4 + 1]); w.y = pk2(o[dt][4 * q4 + 2], o[dt][4 * q4 + 3]);
                  *(LAS v2u*)(st + n * OT_ROW + (32 * dt + 8 * q4 + 4 * hh) * 2) = w; }
#pragma unroll
          for (int k = 0; k < 8; ++k) { const int row = 4 * k + (F.lane >> 4);
              const v4u x = *(const LAS v4u*)(st + row * OT_ROW + (F.lane & 15) * 16);
              *(v4u*)(OBP + (size_t)(b * SEQ + q0 + row) * WA + h * HD + (F.lane & 15) * 8) = x; } }
    }
}
__device__ __forceinline__ void p_combine(LAS unsigned char* lds_) {
    Frame F; F.init(lds_); const kptr_t KP = kargs();
    const bf16* OAP = P_OAP; const bf16* OBP = P_OBP; const float* LSE = P_LSE; bf16* MIX = P_MIX;
    const int hd = F.lane >> 3, c0 = F.lane * 16;
    for (int tb = F.gw; tb < T; tb += 2 * F.ngw) {
        v4u ra[2][3][2], rb[2][2]; float ls[2][3];
#pragma unroll
        for (int q = 0; q < 2; ++q) { const int t = (tb + q * F.ngw < T) ? tb + q * F.ngw : tb;
#pragma unroll
            for (int p = 0; p < 3; ++p) { const v4u* sp = (const v4u*)(OAP + ((size_t)p * T + t) * WA + c0); ra[q][p][0] = sp[0]; ra[q][p][1] = sp[1]; ls[q][p] = LSE[((size_t)p * T + t) * 8 + hd]; }
            const v4u* sb = (const v4u*)(OBP + (size_t)t * WA + c0); rb[q][0] = sb[0]; rb[q][1] = sb[1]; }
#pragma unroll
        for (int q = 0; q < 2; ++q) {
            const int t = tb + q * F.ngw;
            const float l0 = ls[q][0], l1 = ls[q][1], l2 = ls[q][2];
            const float mx = fmaxf(l0, fmaxf(l1, l2)), e0 = __expf(l0 - mx), e1 = __expf(l1 - mx), e2 = __expf(l2 - mx), inv = 1.f / (e0 + e1 + e2);
            const float w[3] = {e0 * inv, e1 * inv, e2 * inv};
            float oa[16];
#pragma unroll
            for (int i = 0; i < 16; ++i) oa[i] = 0.f;
#pragma unroll
            for (int p = 0; p < 3; ++p) {
                const v4u a = ra[q][p][0], c = ra[q][p][1];
                const unsigned ww[8] = {a.x, a.y, a.z, a.w, c.x, c.y, c.z, c.w};
#pragma unroll
                for (int i = 0; i < 8; ++i) { oa[2 * i] += w[p] * bflo(ww[i]); oa[2 * i + 1] += w[p] * bfhi(ww[i]); }
            }
            float ob[16];
            { const v4u a = rb[q][0], c = rb[q][1];
              const unsigned ww[8] = {a.x, a.y, a.z, a.w, c.x, c.y, c.z, c.w};
#pragma unroll
              for (int i = 0; i < 8; ++i) { ob[2 * i] = bflo(ww[i]); ob[2 * i + 1] = bfhi(ww[i]); } }
            float sa = 0.f, sb = 0.f;
#pragma unroll
            for (int i = 0; i < 16; ++i) { sa += oa[i] * oa[i]; sb += ob[i] * ob[i]; }
            const float ra_ = rsqrtf(wave_sum(sa) * (1.f / WA) + EPS), rb_ = rsqrtf(wave_sum(sb) * (1.f / WA) + EPS);
            v4u x0, x1, y0, y1;
            x0.x = pk2(oa[0] * ra_, oa[1] * ra_); x0.y = pk2(oa[2] * ra_, oa[3] * ra_); x0.z = pk2(oa[4] * ra_, oa[5] * ra_); x0.w = pk2(oa[6] * ra_, oa[7] * ra_);
            x1.x = pk2(oa[8] * ra_, oa[9] * ra_); x1.y = pk2(oa[10] * ra_, oa[11] * ra_); x1.z = pk2(oa[12] * ra_, oa[13] * ra_); x1.w = pk2(oa[14] * ra_, oa[15] * ra_);
            y0.x = pk2(ob[0] * rb_, ob[1] * rb_); y0.y = pk2(ob[2] * rb_, ob[3] * rb_); y0.z = pk2(ob[4] * rb_, ob[5] * rb_); y0.w = pk2(ob[6] * rb_, ob[7] * rb_);
            y1.x = pk2(ob[8] * rb_, ob[9] * rb_); y1.y = pk2(ob[10] * rb_, ob[11] * rb_); y1.z = pk2(ob[12] * rb_, ob[13] * rb_); y1.w = pk2(ob[14] * rb_, ob[15] * rb_);
            if (t < T) { v4u* dA = (v4u*)(MIX + (size_t)t * D + c0); dA[0] = x0; dA[1] = x1;
                         v4u* dB = (v4u*)(MIX + (size_t)t * D + WA + c0); dB[0] = y0; dB[1] = y1; }
        }
    }
}

__device__ __forceinline__ unsigned f2sort(float f) { const unsigned u = __builtin_bit_cast(unsigned, f); return (u & 0x80000000u) ? ~u : (u | 0x80000000u); }
__device__ __forceinline__ float sort2f(unsigned k) { const unsigned u = (k & 0x80000000u) ? (k & 0x7fffffffu) : ~k; return __builtin_bit_cast(float, u); }
__device__ __forceinline__ unsigned umax(unsigned a, unsigned b) { return a > b ? a : b; }
__device__ __forceinline__ unsigned umin(unsigned a, unsigned b) { return a < b ? a : b; }
#define CE_DESC(x, y) do { const unsigned hi_ = umax(x, y), lo_ = umin(x, y); x = hi_; y = lo_; } while (0)
#define CE_ASC(x, y) do { const unsigned hi_ = umax(x, y), lo_ = umin(x, y); x = lo_; y = hi_; } while (0)
__device__ __forceinline__ void sort16_desc(unsigned (&a)[64], const int base) {
#pragma unroll
    for (int k = 2; k <= 16; k <<= 1)
#pragma unroll
        for (int j = k >> 1; j >= 1; j >>= 1)
#pragma unroll
            for (int i = 0; i < 16; ++i) { const int l = i ^ j; if (l > i) { if ((i & k) == 0) CE_DESC(a[base + i], a[base + l]); else CE_ASC(a[base + i], a[base + l]); } }
}
__device__ __forceinline__ void merge_top16(const unsigned* A, const unsigned* B, unsigned (&c)[16]) {
#pragma unroll
    for (int i = 0; i < 16; ++i) c[i] = umax(A[i], B[15 - i]);
#pragma unroll
    for (int st = 8; st >= 1; st >>= 1)
#pragma unroll
        for (int i = 0; i < 16; ++i) if ((i & st) == 0) CE_DESC(c[i], c[i + st]);
}
__device__ __forceinline__ void top16_of64(unsigned (&keys)[64], unsigned (&res)[16]) {
    sort16_desc(keys, 0); sort16_desc(keys, 16); sort16_desc(keys, 32); sort16_desc(keys, 48);
    unsigned X[16], Y[16];
    merge_top16(keys, keys + 16, X); merge_top16(keys + 32, keys + 48, Y); merge_top16(X, Y, res);
}
__device__ __forceinline__ unsigned sel4(unsigned w0, unsigned w1, unsigned w2, unsigned w3, int a) {
    const unsigned lo = (a & 4) ? w1 : w0, hi = (a & 4) ? w3 : w2, x = (a & 8) ? hi : lo;
    return (x >> (8 * (a & 3))) & 0xffu;
}
__device__ __forceinline__ void topk_half(const bf16* qp, const bf16* kp0, int hh, unsigned (&L)[16]) {
    bf16x8 qf[8];
#pragma unroll
    for (int s = 0; s < 8; ++s) qf[s] = *(const bf16x8*)(qp + 16 * s);
    unsigned keys[64];
#pragma unroll
    for (int kt = 0; kt < 4; ++kt) {
        f32x16 S;
#pragma unroll
        for (int i = 0; i < 16; ++i) S[i] = 0.f;
        const bf16* kp = kp0 + (size_t)(32 * kt) * 128;
#pragma unroll
        for (int s = 0; s < 8; ++s) { const bf16x8 kf = *(const bf16x8*)(kp + 16 * s); S = MFMA32(kf, qf[s], S); }
#pragma unroll
        for (int i = 0; i < 16; ++i) { const int nidx = 32 * kt + (i & 3) + 8 * (i >> 2) + 4 * hh; keys[16 * kt + i] = (f2sort(S[i]) & ~0x7fu) | (unsigned)(127 - nidx); }
        asm volatile("" ::: "memory");
    }
    unsigned mine[16], oth[16];
    top16_of64(keys, mine);
#pragma unroll
    for (int k = 0; k < 16; ++k) oth[k] = (unsigned)__shfl_xor((int)mine[k], 32);
#pragma unroll
    for (int k = 0; k < 16; ++k) L[k] = umax(mine[k], oth[15 - k]);
#pragma unroll
    for (int st = 8; st >= 1; st >>= 1)
#pragma unroll
        for (int k = 0; k < 16; ++k) if ((k & st) == 0) { const unsigned hi = umax(L[k], L[k + st]), lo = umin(L[k], L[k + st]); L[k] = hi; L[k + st] = lo; }
}
#define PINU16(x) asm volatile("" : "+v"(x[0]), "+v"(x[1]), "+v"(x[2]), "+v"(x[3]), "+v"(x[4]), "+v"(x[5]), "+v"(x[6]), "+v"(x[7]), "+v"(x[8]), "+v"(x[9]), "+v"(x[10]), "+v"(x[11]), "+v"(x[12]), "+v"(x[13]), "+v"(x[14]), "+v"(x[15]) :: "memory")
__device__ __forceinline__ void p_peer_topk(LAS unsigned char* lds_, int layer) {
    Frame F; F.init(lds_); const kptr_t KP = kargs();
    const bf16* SKB = P_SKB + (size_t)layer * PH * 2 * NKEYS * 128;
    const int n = F.lane & 31, hh = F.lane >> 5;
    for (int item = F.gw; item < (T / 32) * PH; item += F.ngw) {
        int nn = n; asm volatile("" : "+v"(nn));
        const int h = item & 7, tb = item >> 3, t = 32 * tb + nn;
        unsigned LA[16], LB[16];
        topk_half(P_QR + (size_t)t * D + h * 256 + 8 * hh, SKB + ((size_t)(h * 2) * NKEYS + nn) * 128 + 8 * hh, hh, LA);
        PINU16(LA);
        topk_half(P_QR + (size_t)t * D + h * 256 + 128 + 8 * hh, SKB + ((size_t)(h * 2 + 1) * NKEYS + nn) * 128 + 8 * hh, hh, LB);
        PINU16(LB);
        float fA[16], fB[16];
#pragma unroll
        for (int k = 0; k < 16; ++k) { fA[k] = sort2f(LA[k] & ~0x7fu); fB[k] = sort2f(LB[k] & ~0x7fu);
        }
#define PK4(L, k) ((127u - (L[k] & 0x7fu)) | ((127u - (L[k + 1] & 0x7fu)) << 8) | ((127u - (L[k + 2] & 0x7fu)) << 16) | ((127u - (L[k + 3] & 0x7fu)) << 24))
        const unsigned pA0 = PK4(LA, 0), pA1 = PK4(LA, 4), pA2 = PK4(LA, 8), pA3 = PK4(LA, 12), pB0 = PK4(LB, 0), pB1 = PK4(LB, 4), pB2 = PK4(LB, 8), pB3 = PK4(LB, 12);
        unsigned cand[64]; int nc = 0;
#pragma unroll
        for (int k = 50; k < 64; ++k) cand[k] = 0u;
#pragma unroll
        for (int a = 0; a < 16; ++a)
#pragma unroll
            for (int bb = 0; bb < 16; ++bb) if ((a + 1) * (bb + 1) <= 16) { cand[nc] = (f2sort(fA[a] + fB[bb]) & ~0xffu) | (unsigned)(255 - (16 * a + bb)); ++nc; }
        unsigned sel[16];
        top16_of64(cand, sel);
        float val[16], ex[16], sum = 0.f; int eid[16];
#pragma unroll
        for (int k = 0; k < 16; ++k) { const int flat = 255 - (int)(sel[k] & 0xffu); val[k] = sort2f(sel[k] & ~0xffu);
            eid[k] = (int)(sel4(pA0, pA1, pA2, pA3, flat >> 4) * NKEYS + sel4(pB0, pB1, pB2, pB3, flat & 15)); }
#pragma unroll
        for (int k = 0; k < 16; ++k) { ex[k] = __expf(val[k] - val[0]); sum += ex[k]; }
        const float inv = 1.f / sum;
        if (hh == 0) {
            int* ip = P_IDS + (size_t)t * 128 + h * 16; float* gp = P_GATES + (size_t)t * 128 + h * 16;
#pragma unroll
            for (int k = 0; k < 16; k += 4) { *(v4u*)(ip + k) = (v4u){(unsigned)eid[k], (unsigned)eid[k + 1], (unsigned)eid[k + 2], (unsigned)eid[k + 3]};
                *(f32x4*)(gp + k) = (f32x4){ex[k] * inv, ex[k + 1] * inv, ex[k + 2] * inv, ex[k + 3] * inv}; }
        }
    }
}
#define SB() asm volatile("" ::: "memory")
__device__ __forceinline__ void sliced_groups(int b, int G, int& grp, int& rank, int& nrank, int& ng) { ng = G < 8 ? G : 8; grp = b % ng; rank = b / ng; nrank = (G - grp + ng - 1) / ng; }
#define PS_TOK(i_) (t0 + (((i_) < n) ? (i_) : (n - 1)) * tstep)
#define PS_IDS(ida, idb, i_) do { const int t_ = PS_TOK(i_); ida = P_IDS[(size_t)t_ * 128 + F.lane]; idb = P_IDS[(size_t)t_ * 128 + 64 + F.lane]; } while (0)
#define PS_ROWS(W, ida, idb, base) do { _Pragma("unroll") for (int j_ = 0; j_ < 16; ++j_) { const int id_ = __shfl((j_ & 8) ? idb : ida, 8 * (j_ & 7) + (F.lane >> 3)); W[j_] = *(const v4u*)((base) + (size_t)id_ * 128); } } while (0)
#define PG_CVT4(w_, b_) __builtin_amdgcn_cvt_scalef32_pk_f32_fp4((unsigned)(w_), 1.0f, (b_))
typedef int v8i_t __attribute__((ext_vector_type(8)));
typedef float f32x4m __attribute__((ext_vector_type(4)));
#define PS_XLD(X, i_) do { const unsigned char* xp_ = P_H8 + (size_t)PS_TOK(i_) * (D / 2) + s * 128 + 16 * xb; \
        X[0] = (v4u){0u, 0u, 0u, 0u}; X[1] = X[0]; \
        if (xuse) { X[0] = *(const v4u*)xp_; X[1] = *(const v4u*)(xp_ + 64); } } while (0)
#define PS_UCOMP(W, X, i_) do { \
        const v8i_t b0_ = (v8i_t){(int)X[0].x, (int)X[0].y, (int)X[0].z, (int)X[0].w, 0, 0, 0, 0}; \
        const v8i_t b1_ = (v8i_t){(int)X[1].x, (int)X[1].y, (int)X[1].z, (int)X[1].w, 0, 0, 0, 0}; \
        float v_[16]; \
        _Pragma("unroll") for (int j_ = 0; j_ < 16; ++j_) { const v8i_t a_ = (v8i_t){(int)W[j_].x, (int)W[j_].y, (int)W[j_].z, (int)W[j_].w, 0, 0, 0, 0}; \
            const f32x4m z4_ = (f32x4m){0.f, 0.f, 0.f, 0.f}; \
            const f32x4m c0_ = __builtin_amdgcn_mfma_scale_f32_16x16x128_f8f6f4(a_, b0_, z4_, 4, 4, 0, 0x7f7f7f7f, 0, 0x7f7f7f7f); \
            const f32x4m c1_ = __builtin_amdgcn_mfma_scale_f32_16x16x128_f8f6f4(a_, b1_, z4_, 4, 4, 0, 0x7f7f7f7f, 0, 0x7f7f7f7f); \
            const float e0_ = csel1 ? c1_[0] : c0_[0], e1_ = csel1 ? c1_[1] : c0_[1], e2_ = csel1 ? c1_[2] : c0_[2], e3_ = csel1 ? c1_[3] : c0_[3]; \
            v_[j_] = (creg & 2) ? ((creg & 1) ? e3_ : e2_) : ((creg & 1) ? e1_ : e0_); } \
        float w8_[8], y4_[4], z0_, z1_; \
        _Pragma("unroll") for (int m_ = 0; m_ < 8; ++m_) { const bool up_ = F.lane & 4; const float keep_ = up_ ? v_[2 * m_ + 1] : v_[2 * m_], send_ = up_ ? v_[2 * m_] : v_[2 * m_ + 1]; w8_[m_] = keep_ + __shfl_xor(send_, 4); } \
        _Pragma("unroll") for (int m_ = 0; m_ < 4; ++m_) { const bool up_ = F.lane & 8; const float keep_ = up_ ? w8_[2 * m_ + 1] : w8_[2 * m_], send_ = up_ ? w8_[2 * m_] : w8_[2 * m_ + 1]; y4_[m_] = keep_ + __shfl_xor(send_, 8); } \
        { const bool up_ = F.lane & 16; z0_ = (up_ ? y4_[1] : y4_[0]) + __shfl_xor(up_ ? y4_[0] : y4_[1], 16); z1_ = (up_ ? y4_[3] : y4_[2]) + __shfl_xor(up_ ? y4_[2] : y4_[3], 16); } \
        asm volatile("" : "+v"(z0_), "+v"(z1_) :: "memory"); \
        if ((i_) < n) ((unsigned*)P_PART)[((size_t)PS_TOK(i_) * 8 + s) * 64 + F.lane] = pk2(z0_, z1_); } while (0)
__device__ __forceinline__ void p_peer_u(LAS unsigned char* lds_, int layer) {
    Frame F; F.init(lds_); const kptr_t KP = kargs();
    int grp, rank, nrank, ng; sliced_groups(F.gw / NWAVES, F.G, grp, rank, nrank, ng);
    const int r = F.lane & 7;
    const bool xuse = (F.lane & 3) == (F.lane >> 4), csel1 = (F.lane >> 4) & 1; const int xb = (F.lane >> 2) & 3, creg = (F.lane >> 2) & 3;
    const int t0 = rank * NWAVES + F.wave, tstep = nrank * NWAVES, n = (T - t0 + tstep - 1) / tstep;
#pragma unroll 1
    for (int s = grp; s < 8; s += ng) {
        const unsigned char* Us = P_U8 + ((size_t)(layer * 8 + s) * NEXP) * 128 + 16 * r;
        int iEa, iEb, iOa, iOb; v4u xE[2], xO[2]; v4u WA[16], WB[16];
        PS_IDS(iEa, iEb, 0); PS_XLD(xE, 0); PS_IDS(iOa, iOb, 1); PS_XLD(xO, 1);
        PS_ROWS(WA, iEa, iEb, Us); SB();
#pragma unroll 1
        for (int i = 0; i < n; i += 2) {
            PS_ROWS(WB, iOa, iOb, Us); PS_IDS(iEa, iEb, i + 2); SB();
            PS_UCOMP(WA, xE, i); PS_XLD(xE, i + 2); SB();
            PS_ROWS(WA, iEa, iEb, Us); PS_IDS(iOa, iOb, i + 3); SB();
            PS_UCOMP(WB, xO, i + 1); PS_XLD(xO, i + 3); SB();
        }
    }
}
__device__ __forceinline__ void p_peer_a(LAS unsigned char* lds_) {
    Frame F; F.init(lds_); const kptr_t KP = kargs();
    const int pl = 8 * ((F.lane >> 2) & 7) + (F.lane >> 5) + 2 * (F.lane & 3);
    for (int tb = F.gw; tb < T; tb += 2 * F.ngw) {
        unsigned pw[2][8]; float gg[2][2], rs[2];
#pragma unroll
        for (int q = 0; q < 2; ++q) { const int t = (tb + q * F.ngw < T) ? tb + q * F.ngw : tb;
            const unsigned* pp = (const unsigned*)P_PART + (size_t)t * 8 * 64 + F.lane;
#pragma unroll
            for (int s = 0; s < 8; ++s) pw[q][s] = pp[s * 64];
            gg[q][0] = P_GATES[(size_t)t * 128 + pl]; gg[q][1] = P_GATES[(size_t)t * 128 + 64 + pl];
            rs[q] = row_rstd(P_SSQ1, t) * (1.f / (USCALE * XS4)); }
#pragma unroll
        for (int q = 0; q < 2; ++q) {
            const int t = tb + q * F.ngw;
            float s0 = 0.f, s1 = 0.f;
#pragma unroll
            for (int s = 0; s < 8; ++s) { s0 += bflo(pw[q][s]); s1 += bfhi(pw[q][s]); }
            const float d0 = s0 * rs[q], d1 = s1 * rs[q];
            if (t < T) {
                P_AG[(size_t)t * 128 + F.lane] = 0.5f * d0 * (1.f + erff(d0 * 0.70710678118654752f)) * (gg[q][0] * (1.f / VSCALE));
                P_AG[(size_t)t * 128 + 64 + F.lane] = 0.5f * d1 * (1.f + erff(d1 * 0.70710678118654752f)) * (gg[q][1] * (1.f / VSCALE)); }
        }
    }
}
#define PS_ALD(aa, ab, hv, i_) do { const int t_ = PS_TOK(i_); aa = P_AG[(size_t)t_ * 128 + F.lane]; ab = P_AG[(size_t)t_ * 128 + 64 + F.lane]; hv = *(const v2u*)(P_HBA + (size_t)t_ * D + coff); } while (0)
typedef _Float16 h2_t __attribute__((ext_vector_type(2)));
#define PG_CVT4H(w_, b_) __builtin_bit_cast(h2_t, __builtin_amdgcn_cvt_scalef32_pk_f16_fp4((unsigned)(w_), 1.0f, (b_)))
#define H2_SHX(v_, k_) __builtin_bit_cast(h2_t, __shfl_xor(__builtin_bit_cast(int, (v_)), (k_)))
#define PS_VFMA4(k0_, w_) do { acc_[(k0_)] = __builtin_elementwise_fma(PG_CVT4H(w_, 0), a_, acc_[(k0_)]); acc_[(k0_) + 1] = __builtin_elementwise_fma(PG_CVT4H(w_, 1), a_, acc_[(k0_) + 1]); \
        acc_[(k0_) + 2] = __builtin_elementwise_fma(PG_CVT4H(w_, 2), a_, acc_[(k0_) + 2]); acc_[(k0_) + 3] = __builtin_elementwise_fma(PG_CVT4H(w_, 3), a_, acc_[(k0_) + 3]); } while (0)
#define PS_VCOMP(W, aa, ab, hv, i_) do { \
        h2_t acc_[16]; \
        _Pragma("unroll") for (int k_ = 0; k_ < 16; ++k_) acc_[k_] = (h2_t){(_Float16)0.f, (_Float16)0.f}; \
        _Pragma("unroll") for (int j_ = 0; j_ < 16; ++j_) { const float aj_ = __shfl((j_ & 8) ? ab : aa, gq + 4 * (j_ & 7)); const _Float16 ah_ = (_Float16)aj_; const h2_t a_ = (h2_t){ah_, ah_}; \
            PS_VFMA4(0, W[j_].x); PS_VFMA4(4, W[j_].y); PS_VFMA4(8, W[j_].z); PS_VFMA4(12, W[j_].w); } \
        h2_t w8_[8], y4_[4], zz_[2]; float z_[4]; \
        _Pragma("unroll") for (int k_ = 0; k_ < 8; ++k_) { const bool up_ = F.lane & 8; const h2_t keep_ = up_ ? acc_[k_ + 8] : acc_[k_], send_ = up_ ? acc_[k_] : acc_[k_ + 8]; w8_[k_] = keep_ + H2_SHX(send_, 8); } \
        _Pragma("unroll") for (int k_ = 0; k_ < 4; ++k_) { const bool up_ = F.lane & 16; const h2_t keep_ = up_ ? w8_[k_ + 4] : w8_[k_], send_ = up_ ? w8_[k_] : w8_[k_ + 4]; y4_[k_] = keep_ + H2_SHX(send_, 16); } \
        _Pragma("unroll") for (int k_ = 0; k_ < 2; ++k_) { const bool up_ = F.lane & 32; const h2_t keep_ = up_ ? y4_[k_ + 2] : y4_[k_], send_ = up_ ? y4_[k_] : y4_[k_ + 2]; zz_[k_] = keep_ + H2_SHX(send_, 32); } \
        z_[0] = (float)zz_[0].x; z_[1] = (float)zz_[0].y; z_[2] = (float)zz_[1].x; z_[3] = (float)zz_[1].y; \
        v2u hn_; hn_.x = pk2(bflo(hv.x) + z_[0], bfhi(hv.x) + z_[1]); hn_.y = pk2(bflo(hv.y) + z_[2], bfhi(hv.y) + z_[3]); \
        float ss_ = wave_sum((bflo(hn_.x) * bflo(hn_.x) + bfhi(hn_.x) * bfhi(hn_.x)) + (bflo(hn_.y) * bflo(hn_.y) + bfhi(hn_.y) * bfhi(hn_.y))); \
        asm volatile("" : "+v"(hn_.x), "+v"(hn_.y), "+v"(ss_) :: "memory"); \
        v2s_t g8_ = (v2s_t){0, 0}; g8_ = __builtin_amdgcn_cvt_scalef32_pk_fp8_f32(g8_, bflo(hn_.x), bfhi(hn_.x), 1.0f, false); g8_ = __builtin_amdgcn_cvt_scalef32_pk_fp8_f32(g8_, bflo(hn_.y), bfhi(hn_.y), 1.0f, true); \
        if ((i_) < n) { const size_t off_ = (size_t)PS_TOK(i_) * D + coff; *(v2u*)(P_HBA + off_) = hn_; *(unsigned*)(P_HG8 + off_) = __builtin_bit_cast(unsigned, g8_);        \
            if (F.lane == 0) { float* sq_ = P_SSQ2 + (size_t)PS_TOK(i_) * 32 + s; sq_[0] = ss_; sq_[8] = 0.f; sq_[16] = 0.f; sq_[24] = 0.f; } } } while (0)
__device__ __forceinline__ void p_peer_v(LAS unsigned char* lds_, int layer) {
    Frame F; F.init(lds_); const kptr_t KP = kargs();
    int grp, rank, nrank, ng; sliced_groups(F.gw / NWAVES, F.G, grp, rank, nrank, ng);
    const int r = F.lane & 7, gq = (((F.lane >> 3) & 1) << 5) | (F.lane >> 4);
    const int gsel = 16 * ((F.lane >> 3) & 1) + 8 * ((F.lane >> 4) & 1) + 4 * ((F.lane >> 5) & 1);
    const int t0 = rank * NWAVES + F.wave, tstep = nrank * NWAVES, n = (T - t0 + tstep - 1) / tstep;
#pragma unroll 1
    for (int s = grp; s < 8; s += ng) {
        const unsigned char* Vs = P_V8 + ((size_t)(layer * 8 + s) * NEXP) * 128 + 16 * r;
        const int coff = s * 256 + 32 * r + gsel;
        int iEa, iEb, iOa, iOb; float aEa, aEb, aOa, aOb; v2u hE, hO; v4u WA[16], WB[16];
        PS_IDS(iEa, iEb, 0); PS_ALD(aEa, aEb, hE, 0); PS_IDS(iOa, iOb, 1); PS_ALD(aOa, aOb, hO, 1);
        PS_ROWS(WA, iEa, iEb, Vs); SB();
#pragma unroll 1
        for (int i = 0; i < n; i += 2) {
            PS_ROWS(WB, iOa, iOb, Vs); PS_IDS(iEa, iEb, i + 2); SB();
            PS_VCOMP(WA, aEa, aEb, hE, i); PS_ALD(aEa, aEb, hE, i + 2); SB();
            PS_ROWS(WA, iEa, iEb, Vs); PS_IDS(iOa, iOb, i + 3); SB();
            PS_VCOMP(WB, aOa, aOb, hO, i + 1); PS_ALD(aOa, aOb, hO, i + 3); SB();
        }
    }
}
__device__ __forceinline__ void p_final(LAS unsigned char* lds_) {
    Frame F; F.init(lds_); const kptr_t KP = kargs();
    for (int t = F.gw; t < T; t += F.ngw) {
        const float rstd = row_rstd(P_SSQ0, t);
#pragma unroll
        for (int j = 0; j < 8; ++j) {
            const size_t c = j * 256 + F.lane * 4;
            const v2u hw = *(const v2u*)(P_HBB + (size_t)t * D + c); const f32x4 h4 = (f32x4){bflo(hw.x), bfhi(hw.x), bflo(hw.y), bfhi(hw.y)}, g = *(const f32x4*)(P_final_norm + c);
            *(f32x4*)(kout(KP) + (size_t)t * D + c) = h4 * rstd * g;
        }
    }
}

__device__ __forceinline__ int lg() { int g_ = gridDim.x; asm volatile("" : "+s"(g_)); return g_; }
__device__ __forceinline__ int lb() { int b_ = blockIdx.x; asm volatile("" : "+s"(b_)); return b_; }
__device__ __forceinline__ void grid_seam(LAS unsigned char* lds) {
    XcdBarrier b; b.bar = (unsigned*)(kws(kargs()) + WS_CTL) + CW_BAR; b.x = xb_xcc_id(); b.st = (volatile LAS unsigned*)(lds + MISC_OFF);
    xcd_barrier(b);
}
template <int L> struct LTag { static constexpr int value = L; };
__global__ void __launch_bounds__(NTHREADS, 2) fwd_kernel(Args args) {
    extern __shared__ __attribute__((aligned(16))) unsigned char lds_raw[];
    LAS unsigned char* lds = (LAS unsigned char*)lds_raw;
    for (int u = threadIdx.x; u < (LDS_BYTES - LDSCTL_OFF) / 4; u += NTHREADS) ((LAS unsigned*)(lds + LDSCTL_OFF))[u] = 0u;
    __syncthreads();
#define PH_LO (*(const int CAS*)(kargs() + 152))
#define PH_HI (*(const int CAS*)(kargs() + 156))
    if (PH_HI - PH_LO > 1) (void)xcd_barrier_post((unsigned*)(kws(kargs()) + WS_CTL) + CW_BAR, (volatile LAS unsigned*)(lds + MISC_OFF));
#ifndef PH_MASK
#define PH_MASK 0x3ff
#endif
#define EN(i) ((PH_MASK >> (i)) & 1)
#define RUN(k) ((k) >= PH_LO && (k) < PH_HI)
#ifdef PROBE_BAR2
#define SEAM(k) do { if ((k) + 1 < PH_HI) { grid_seam(lds); grid_seam(lds); } } while (0)
#else
#define SEAM(k) do { if ((k) + 1 < PH_HI) grid_seam(lds); } while (0)
#endif

    #ifdef PROBE_PRO2
    if (EN(0) && RUN(0)) { p_prologue(lds); __syncthreads(); }
#endif
    if (EN(0) && RUN(0)) { p_prologue(lds); SEAM(0); }
    auto layer_body = [&](auto layer_tag) __attribute__((always_inline)) {
        constexpr int layer = decltype(layer_tag)::value;
        const int ph0 = 1 + layer * PHASES_PER_LAYER;
        if (EN(1) && RUN(ph0 + 0)) {
            { const kptr_t KP = kargs();
              pg8::Gemm g{P_HBB, P_Wt_in + (size_t)layer * INW * D, T, QW, D}; pg8::StaticOrder S; S.init(T, QW, lg(), lb());
#ifdef PROBE_GEMM2
              { EpiNull E0{0}; pg8::gemm_phase<EpiNull, pg8::StaticOrder, true, true>(lds, g, S, E0); }
#endif
              EpiInProj E{0};
              pg8::gemm_phase<EpiInProj, pg8::StaticOrder, true, true>(lds, g, S, E); }
            { const kptr_t KP = kargs();
              pg8::Gemm g{P_HBB, P_Wt_in + (size_t)layer * INW * D + (size_t)QW * D, T, 1024, D}; pg8::StaticOrder S; S.init(T, 1024, lg(), lb());
              EpiVa E{0};
              pg8::gemm_phase<EpiVa, pg8::StaticOrder, true, true>(lds, g, S, E); }
            { const kptr_t KP = kargs();
              pg8::Gemm g{P_Wt_in + (size_t)layer * INW * D + (size_t)5120 * D, P_HBB, 1024, T, D}; pg8::StaticOrder S; S.init(1024, T, lg(), lb());
#ifdef PROBE_GEMM2
              { EpiNull E0{0}; pg8::gemm_phase<EpiNull, pg8::StaticOrder, true, true>(lds, g, S, E0); }
#endif
              EpiVbT E{0};
              pg8::gemm_phase<EpiVbT, pg8::StaticOrder, true, true>(lds, g, S, E); }
            SEAM(ph0 + 0); }
        if (EN(2) && RUN(ph0 + 1)) {
#ifdef PROBE_ATT2
            p_attn_dilated(lds); p_attn_stick(lds);
#endif
#ifdef PROBE_DIL2
            p_attn_dilated(lds);
#endif
#ifdef PROBE_STK2
            p_attn_stick(lds);
#endif
#ifndef NO_DIL
            p_attn_dilated(lds);
#endif
#ifndef NO_STICK
            p_attn_stick(lds);
#endif
            SEAM(ph0 + 1); }
        if (EN(3) && RUN(ph0 + 2)) {
#ifdef PROBE_COMB2
            p_combine(lds);
#endif
            p_combine(lds); SEAM(ph0 + 2); }
        if (EN(4) && RUN(ph0 + 3)) {
            const kptr_t KP = kargs();
            pg8::Gemm g{P_MIX, P_Wt_out + (size_t)layer * D * D, T, D, D}; pg8::StaticOrder S; S.init(T, D, lg(), lb());
#ifdef PROBE_GEMM2
            { EpiNull E0{0}; pg8::gemm_phase<EpiNull, pg8::StaticOrder, true, true>(lds, g, S, E0); }
#endif
            EpiResid<0> E{0};
            pg8::gemm_phase<EpiResid<0>, pg8::StaticOrder, true, true>(lds, g, S, E);
            SEAM(ph0 + 3); }
        if (EN(5) && RUN(ph0 + 4)) {
            { const kptr_t KP = kargs();
              pg8::Gemm g{P_HBA, P_Wt_q + (size_t)layer * D * D, T, D, D}; pg8::StaticOrder S; S.init(T, D, lg(), lb());
#ifdef PROBE_GEMM2
              { EpiNull E0{0}; pg8::gemm_phase<EpiNull, pg8::StaticOrder, true, true>(lds, g, S, E0); }
#endif
              EpiBf16Scale E{0};
              pg8::gemm_phase<EpiBf16Scale, pg8::StaticOrder, true, true>(lds, g, S, E); }
            { const kptr_t KP = kargs();
              pg8::Gemm g{P_PB + (size_t)layer * T * PLE, P_Wt_p + (size_t)layer * D * PLE, T, D, PLE}; pg8::StaticOrder S; S.init(T, D, lg(), lb());
#ifdef PROBE_GEMM2
              { EpiNull E0{0}; pg8::gemm_phase<EpiNull, pg8::StaticOrder, true, true>(lds, g, S, E0); }
#endif
              EpiBf16Scale E{1};
              pg8::gemm_phase<EpiBf16Scale, pg8::StaticOrder, true, true>(lds, g, S, E); }
            SEAM(ph0 + 4); }
        if (EN(6) && RUN(ph0 + 5)) {
#ifdef PROBE_TOPK2
            p_peer_topk(lds, layer);
#endif
            p_peer_topk(lds, layer); SEAM(ph0 + 5); }
        if (EN(7) && RUN(ph0 + 6)) {
#ifdef PROBE_U2
            p_peer_u(lds, layer);
#endif
            p_peer_u(lds, layer); SEAM(ph0 + 6); }
        if (EN(7) && RUN(ph0 + 7)) {
#ifdef PROBE_A2
            p_peer_a(lds);
#endif
            p_peer_a(lds); SEAM(ph0 + 7); }
        if (EN(7) && RUN(ph0 + 8)) { p_peer_v(lds, layer); SEAM(ph0 + 8); }
        if (EN(8) && RUN(ph0 + 9)) {
            const kptr_t KP = kargs();
#ifdef GATE_BF16
            pg8::Gemm g{P_HBA, P_Wt_g + (size_t)layer * D * D, T, D, D}; pg8::StaticOrder S; S.init(T, D, lg(), lb());
#else
            pg8::Gemm g{(const bf16*)P_HG8, (const bf16*)(P_WG8 + (size_t)layer * D * D), T, D, D}; pg8::StaticOrder S; S.init(T, D, lg(), lb());
#endif
#ifdef PROBE_GEMM2
            { EpiNull E0{0}; pg8::gemm_phase<EpiNull, pg8::StaticOrder, true, true>(lds, g, S, E0); }
#endif
            EpiResid<1> E{0};
#ifdef GATE_BF16
            pg8::gemm_phase<EpiResid<1>, pg8::StaticOrder, true, true>(lds, g, S, E);
#else
            pg8::gemm_phase<EpiResid<1>, pg8::StaticOrder, true, true, 1, 121>(lds, g, S, E);
#endif
            SEAM(ph0 + 9); }
    };
    layer_body(LTag<0>{}); layer_body(LTag<1>{}); layer_body(LTag<2>{}); layer_body(LTag<3>{});
    static_assert(DEPTH == 4, "four copies");
    if (EN(9) && RUN(NPH - 1)) { p_final(lds); }
#undef RUN
#undef SEAM
}

extern "C" void kernel_launch(void* const* d_in, const int* in_sizes, int n_in, void* d_out, int out_size, void* d_ws, size_t ws_size, hipStream_t stream) {
    static int grid = 0;
    if (grid == 0) {
        if (n_in != 17 || out_size != T * D || ws_size < WS_END) { fprintf(stderr, "kernel_launch: unexpected shapes (n_in %d out %d ws %zu need %zu)\n", n_in, out_size, ws_size, (size_t)WS_END); grid = -1; return; }
        int dev = 0, cus = 0, per_cu = 0;
        if (hipGetDevice(&dev) != hipSuccess || hipDeviceGetAttribute(&cus, hipDeviceAttributeMultiprocessorCount, dev) != hipSuccess) { grid = -1; return; }
        if (hipFuncSetAttribute((const void*)fwd_kernel, hipFuncAttributeMaxDynamicSharedMemorySize, LDS_BYTES) != hipSuccess) { fprintf(stderr, "kernel_launch: hipFuncSetAttribute failed\n"); grid = -1; return; }
        if (hipOccupancyMaxActiveBlocksPerMultiprocessor(&per_cu, (const void*)fwd_kernel, NTHREADS, LDS_BYTES) != hipSuccess || per_cu < 1) { fprintf(stderr, "kernel_launch: occupancy query says %d\n", per_cu); }
        (void)hipGetLastError();
        grid = cus;
    }
    if (grid < 0) return;
    (void)hipMemsetAsync((char*)d_ws + WS_CTL, 0, CTL_ZERO_BYTES, stream);
    Args a{};
    for (int i = 0; i < 17; ++i) a.in[i] = d_in[i];
    a.out = (float*)d_out; a.ws = (unsigned char*)d_ws;
    if (MK_N_LAUNCHES == 1) {
        a.ph_lo = 0; a.ph_hi = NPH;
        hipLaunchKernelGGL(fwd_kernel, dim3(grid), dim3(NTHREADS), LDS_BYTES, stream, a);
    } else {
        for (int k = 0; k < NPH; ++k) { a.ph_lo = k; a.ph_hi = k + 1; hipLaunchKernelGGL(fwd_kernel, dim3(grid), dim3(NTHREADS), LDS_BYTES, stream, a); }
    }
    const hipError_t le = hipPeekAtLastError();
    if (le != hipSuccess) fprintf(stderr, "kernel_launch: launch failed: %s\n", hipGetErrorName(le));
}
```
